# Optimizing an MI355X kernel written in HIP

```python
import math
import jax, jax.numpy as jnp
from jax import lax
import numpy as np

D_MODEL = 1024
BATCH = 32
SEQ = 2048
DEPTH = 4
DEC_BATCH = 8
DEC_SEQ = 32
PAST_LEN = 1024

CHUNK = 64
N_A = DEPTH // 2
N_B = DEPTH - N_A
POOL_WINDOWS = (2, 4, 8, 16)
N_POOL_GROUPS = len(POOL_WINDOWS)
POOL_GROUP = D_MODEL // N_POOL_GROUPS
POOL_STATE = max(POOL_WINDOWS) - 1
N_HEADS = D_MODEL // 128
QK_NOPE = 128
QK_ROPE = 64
V_HEAD = 128
KV_LORA = D_MODEL // 4
Q_LORA = 3 * D_MODEL // 8
D_FF = ((8 * D_MODEL // 3 + 127) // 128) * 128
ROPE_BASE = 10000.0
Q_BLOCK = 128
EPS = 1e-6
ATTN_SCALE = (QK_NOPE + QK_ROPE) ** -0.5

kernel_name = "yoco_pool_mla_streaming_step"


def rms_norm(x, g):
    xf = x.astype(jnp.float32)
    y = xf * lax.rsqrt(jnp.mean(xf * xf, axis=-1, keepdims=True) + EPS)
    return (y * g.astype(jnp.float32)).astype(x.dtype)


def swiglu(h, w_in, w_out):
    gate, up = jnp.split(h @ w_in, 2, axis=-1)
    return (jax.nn.silu(gate) * up) @ w_out


def rope(x, pos):
    half = x.shape[-1] // 2
    inv = ROPE_BASE ** (-(jnp.arange(0, x.shape[-1], 2, dtype=jnp.float32) / x.shape[-1]))
    ang = pos.astype(jnp.float32)[:, None] * inv[None, :]
    cos = jnp.cos(ang)[None, :, None, :]
    sin = jnp.sin(ang)[None, :, None, :]
    xf = x.astype(jnp.float32)
    x1, x2 = xf[..., :half], xf[..., half:]
    return jnp.concatenate([x1 * cos - x2 * sin, x2 * cos + x1 * sin], axis=-1).astype(x.dtype)


def pool_mix(h, prev, start, w_pool, scale):
    B, S, _ = h.shape
    ext = jnp.concatenate([prev.astype(h.dtype), h], axis=1)
    pos_ext = start - POOL_STATE + jnp.arange(POOL_STATE + S)
    extf = jnp.where((pos_ext >= 0)[None, :, None], ext.astype(jnp.float32), 0.0)
    cs = jnp.concatenate([jnp.zeros((B, 1, D_MODEL), jnp.float32), jnp.cumsum(extf, axis=1)], axis=1)
    pos = start + jnp.arange(S)
    end = cs[:, POOL_STATE + 1:]
    hf = h.astype(jnp.float32)
    diffs = []
    for g, w in enumerate(POOL_WINDOWS):
        lo, hi = g * POOL_GROUP, (g + 1) * POOL_GROUP
        begin = cs[:, POOL_STATE + 1 - w:POOL_STATE + 1 - w + S, lo:hi]
        cnt = jnp.minimum(pos + 1, w).astype(jnp.float32)[None, :, None]
        diffs.append((end[..., lo:hi] - begin) / cnt - hf[..., lo:hi])
    d = jnp.stack(diffs, axis=2).astype(h.dtype)
    out = jnp.einsum('bsgc,gcd->bsgd', d, w_pool).reshape(B, S, D_MODEL)
    return out * scale, ext[:, -POOL_STATE:]


def mla_shared_latent(x, pos, kv_norm, w_dkv, c_norm, w_kr, kr_norm):
    h = rms_norm(x, kv_norm)
    c = rms_norm(h @ w_dkv, c_norm)
    kr = rope(rms_norm(h @ w_kr, kr_norm)[:, :, None, :], pos)[:, :, 0]
    return c, kr


def mla_shared_kv(c_all, w_uk, kn_norm, w_uv):
    B, T, _ = c_all.shape
    k_nope = rms_norm((c_all @ w_uk).reshape(B, T, N_HEADS, QK_NOPE), kn_norm)
    v = (c_all @ w_uv).reshape(B, T, N_HEADS, V_HEAD)
    return k_nope, v


def mla_attend(h, pos, start, P, k_nope, k_rope, v, w_dq, q_lat_norm, w_uq, qn_norm, qr_norm, w_o):
    B, S, _ = h.shape
    q_lat = rms_norm(h @ w_dq, q_lat_norm)
    q = (q_lat @ w_uq).reshape(B, S, N_HEADS, QK_NOPE + QK_ROPE)
    q_nope = rms_norm(q[..., :QK_NOPE], qn_norm)
    q_rope = rope(rms_norm(q[..., QK_NOPE:], qr_norm), pos)
    outs = []
    for qb in range(-(-S // Q_BLOCK)):
        q0 = qb * Q_BLOCK
        q1 = min(S, q0 + Q_BLOCK)
        nk = P + q1
        s = (jnp.einsum('bqhd,bkhd->bhqk', q_nope[:, q0:q1], k_nope[:, :nk], preferred_element_type=jnp.float32)
             + jnp.einsum('bqhr,bkr->bhqk', q_rope[:, q0:q1], k_rope[:, :nk], preferred_element_type=jnp.float32)) * ATTN_SCALE
        qc = (start + jnp.arange(q0, q1)) // CHUNK
        kc = (start - P + jnp.arange(nk)) // CHUNK
        s = jnp.where((kc[None, :] <= qc[:, None])[None, None], s, -jnp.inf)
        p = jax.nn.softmax(s, axis=-1)
        outs.append(jnp.einsum('bhqk,bkhd->bqhd', p.astype(v.dtype), v[:, :nk]))
    o = jnp.concatenate(outs, axis=1).reshape(B, S, N_HEADS * V_HEAD)
    return o @ w_o


def trunk(x, pool_prev, ckv_past, kr_past, start,
          ffn1_norm, ffn1_w_in, ffn1_w_out, mix_norm, ffn2_norm, ffn2_w_in, ffn2_w_out,
          pool_w, pool_scale, kv_norm, w_dkv, c_norm, w_kr, kr_norm, w_uk, kn_norm, w_uv,
          w_dq, q_lat_norm, w_uq, qn_norm, qr_norm, w_o):
    B, S, _ = x.shape
    P = ckv_past.shape[1]
    pos = start + jnp.arange(S, dtype=jnp.int32)
    new_pool = []
    c_new = kr_new = k_nope = k_rope = v = None
    for layer in range(DEPTH):
        if layer == N_A:
            c_new, kr_new = mla_shared_latent(x, pos, kv_norm, w_dkv, c_norm, w_kr, kr_norm)
            c_all = jnp.concatenate([ckv_past.astype(c_new.dtype), c_new], axis=1)
            k_rope = jnp.concatenate([kr_past.astype(kr_new.dtype), kr_new], axis=1)
            k_nope, v = mla_shared_kv(c_all, w_uk, kn_norm, w_uv)
        x = x + 0.5 * swiglu(rms_norm(x, ffn1_norm[layer]), ffn1_w_in[layer], ffn1_w_out[layer])
        h = rms_norm(x, mix_norm[layer])
        if layer < N_A:
            m, st = pool_mix(h, pool_prev[layer], start, pool_w[layer], pool_scale[layer])
            new_pool.append(st)
        else:
            i = layer - N_A
            m = mla_attend(h, pos, start, P, k_nope, k_rope, v, w_dq[i], q_lat_norm[i], w_uq[i],
                           qn_norm[i], qr_norm[i], w_o[i])
        x = x + m
        x = x + 0.5 * swiglu(rms_norm(x, ffn2_norm[layer]), ffn2_w_in[layer], ffn2_w_out[layer])
    return x, jnp.stack(new_pool, axis=0), c_new, kr_new


def setup_inputs(seed: int = 0) -> dict:
    key = jax.random.key(seed)
    ks = jax.random.split(key, 40)
    f32 = jnp.float32
    nrm = lambda k, shape, s: jax.random.normal(k, shape, f32) * s
    gain = lambda k, shape: 1.0 + 0.01 * jax.random.normal(k, shape, f32)
    HQ = N_HEADS * (QK_NOPE + QK_ROPE)
    return {
        'x_prompt': nrm(ks[0], (BATCH, SEQ, D_MODEL), 1.0),
        'x_sample': nrm(ks[1], (DEC_BATCH, DEC_SEQ, D_MODEL), 1.0),
        'state_pool': nrm(ks[2], (N_A, DEC_BATCH, POOL_STATE, D_MODEL), 1.0),
        'cache_ckv': nrm(ks[3], (DEC_BATCH, PAST_LEN, KV_LORA), 1.0),
        'cache_krope': nrm(ks[4], (DEC_BATCH, PAST_LEN, QK_ROPE), 1.0),
        'ffn1_norm': gain(ks[5], (DEPTH, D_MODEL)),
        'ffn1_w_in': nrm(ks[6], (DEPTH, D_MODEL, 2 * D_FF), D_MODEL ** -0.5),
        'ffn1_w_out': nrm(ks[7], (DEPTH, D_FF, D_MODEL), D_FF ** -0.5),
        'mix_norm': gain(ks[8], (DEPTH, D_MODEL)),
        'ffn2_norm': gain(ks[9], (DEPTH, D_MODEL)),
        'ffn2_w_in': nrm(ks[10], (DEPTH, D_MODEL, 2 * D_FF), D_MODEL ** -0.5),
        'ffn2_w_out': nrm(ks[11], (DEPTH, D_FF, D_MODEL), D_FF ** -0.5),
        'pool_w': nrm(ks[12], (N_A, N_POOL_GROUPS, POOL_GROUP, POOL_GROUP), POOL_GROUP ** -0.5),
        'pool_scale': 0.5 + 0.05 * jax.random.normal(ks[13], (N_A, D_MODEL), f32),
        'kv_norm': gain(ks[14], (D_MODEL,)),
        'w_dkv': nrm(ks[15], (D_MODEL, KV_LORA), D_MODEL ** -0.5),
        'c_norm': gain(ks[16], (KV_LORA,)),
        'w_kr': nrm(ks[17], (D_MODEL, QK_ROPE), D_MODEL ** -0.5),
        'kr_norm': gain(ks[18], (QK_ROPE,)),
        'w_uk': nrm(ks[19], (KV_LORA, N_HEADS * QK_NOPE), KV_LORA ** -0.5),
        'kn_norm': gain(ks[20], (QK_NOPE,)),
        'w_uv': nrm(ks[21], (KV_LORA, N_HEADS * V_HEAD), KV_LORA ** -0.5),
        'w_dq': nrm(ks[22], (N_B, D_MODEL, Q_LORA), D_MODEL ** -0.5),
        'q_lat_norm': gain(ks[23], (N_B, Q_LORA)),
        'w_uq': nrm(ks[24], (N_B, Q_LORA, HQ), Q_LORA ** -0.5),
        'qn_norm': gain(ks[25], (N_B, QK_NOPE)),
        'qr_norm': gain(ks[26], (N_B, QK_ROPE)),
        'w_o': nrm(ks[27], (N_B, N_HEADS * V_HEAD, D_MODEL), (N_HEADS * V_HEAD) ** -0.5),
    }


def reference(x_prompt, x_sample, state_pool, cache_ckv, cache_krope,
              ffn1_norm, ffn1_w_in, ffn1_w_out, mix_norm, ffn2_norm, ffn2_w_in, ffn2_w_out,
              pool_w, pool_scale, kv_norm, w_dkv, c_norm, w_kr, kr_norm, w_uk, kn_norm, w_uv,
              w_dq, q_lat_norm, w_uq, qn_norm, qr_norm, w_o):
    Bp = x_prompt.shape[0]
    pool_prev_p = jnp.zeros((N_A, Bp, POOL_STATE, D_MODEL), x_prompt.dtype)
    ckv_prev_p = jnp.zeros((Bp, 0, KV_LORA), x_prompt.dtype)
    kr_prev_p = jnp.zeros((Bp, 0, QK_ROPE), x_prompt.dtype)
    y_prompt, new_pool_prompt, new_ckv_prompt, new_krope_prompt = trunk(
        x_prompt, pool_prev_p, ckv_prev_p, kr_prev_p, 0,
        ffn1_norm, ffn1_w_in, ffn1_w_out, mix_norm, ffn2_norm, ffn2_w_in, ffn2_w_out,
        pool_w, pool_scale, kv_norm, w_dkv, c_norm, w_kr, kr_norm, w_uk, kn_norm, w_uv,
        w_dq, q_lat_norm, w_uq, qn_norm, qr_norm, w_o)
    y_sample, new_pool_sample, new_ckv_sample, new_krope_sample = trunk(
        x_sample, state_pool, cache_ckv, cache_krope, cache_ckv.shape[1],
        ffn1_norm, ffn1_w_in, ffn1_w_out, mix_norm, ffn2_norm, ffn2_w_in, ffn2_w_out,
        pool_w, pool_scale, kv_norm, w_dkv, c_norm, w_kr, kr_norm, w_uk, kn_norm, w_uv,
        w_dq, q_lat_norm, w_uq, qn_norm, qr_norm, w_o)
    return (y_prompt, y_sample, new_pool_prompt, new_pool_sample,
            new_ckv_prompt, new_krope_prompt, new_ckv_sample, new_krope_sample)
```

```cpp
#include <hip/hip_runtime.h>
#include <hip/hip_cooperative_groups.h>
#include <cstdio>
#include <cstdint>
namespace cg = cooperative_groups;

#define LAS __attribute__((address_space(3)))
typedef unsigned short bf16_t;
typedef short bf16x8 __attribute__((ext_vector_type(8)));
typedef float f32x4 __attribute__((ext_vector_type(4)));
typedef float f32x2 __attribute__((ext_vector_type(2)));
typedef float f32x16 __attribute__((ext_vector_type(16)));
typedef unsigned u32x4 __attribute__((ext_vector_type(4)));
typedef unsigned u32x2 __attribute__((ext_vector_type(2)));

constexpr int DM = 1024, FF = 2816, TP = 65536, TS = 256, T = TP + TS, SEQ = 2048, NBATCH = 32, DBATCH = 8, DSEQ = 32, PAST = 1024;
constexpr int SKEY = 1088;
constexpr int TALL = TP + DBATCH * SKEY;
constexpr int KVL = 256, QL = 384, HQ = 1536, NH = 8, LATW = 320;
constexpr float EPS = 1e-6f;
constexpr int NTHREADS = 512;
constexpr int LDS_BYTES = 131072 + 1024;

constexpr size_t OUT_Y = 0;
constexpr size_t OUT_POOL_P = (size_t)T * DM;
constexpr size_t OUT_POOL_S = OUT_POOL_P + (size_t)2 * 32 * 15 * 1024;
constexpr size_t OUT_CKV_P = OUT_POOL_S + (size_t)2 * 8 * 15 * 1024;
constexpr size_t OUT_KR_P = OUT_CKV_P + (size_t)TP * 256;
constexpr size_t OUT_CKV_S = OUT_KR_P + (size_t)TP * 64;
constexpr size_t OUT_KR_S = OUT_CKV_S + (size_t)TS * 256;

constexpr size_t SZ_WIN = (size_t)5632 * 1024 * 2, SZ_WOUT = (size_t)1024 * 2816 * 2;
constexpr size_t WS_WIN = 0;
constexpr size_t WS_WOUT = WS_WIN + 8 * SZ_WIN;
constexpr size_t WS_WPOOL = WS_WOUT + 8 * SZ_WOUT;
constexpr size_t WS_WDKV = WS_WPOOL + (size_t)2 * 1024 * 256 * 2;
constexpr size_t WS_WUK = WS_WDKV + (size_t)512 * 1024 * 2;
constexpr size_t WS_WUV = WS_WUK + (size_t)1024 * 256 * 2;
constexpr size_t WS_WDQ = WS_WUV + (size_t)1024 * 256 * 2;
constexpr size_t WS_WUQ = WS_WDQ + (size_t)2 * 512 * 1024 * 2;
constexpr size_t WS_WO = WS_WUQ + (size_t)2 * 1536 * 384 * 2;
constexpr size_t WS_XB = WS_WO + (size_t)2 * 1024 * 1024 * 2;
constexpr size_t WS_H = WS_XB + (size_t)T * 1024 * 2;
constexpr size_t SZ_H = (size_t)T * FF * 2;
constexpr size_t WS_D = WS_H;
constexpr size_t WS_LATRAW = WS_H;
constexpr size_t WS_CALL = WS_H + (size_t)T * LATW * 4;
constexpr size_t WS_Q = WS_H;
constexpr size_t WS_O = WS_H + (size_t)T * HQ * 2;
constexpr size_t WS_DQRAW = WS_O;
constexpr size_t WS_KN = WS_H + SZ_H;
constexpr size_t WS_VT = WS_KN + (size_t)TALL * 1024 * 2;
constexpr size_t WS_KR = WS_VT + (size_t)TALL * 1024 * 2;
constexpr size_t WS_QLAT = WS_KR + (size_t)TALL * 64 * 2;
constexpr size_t WS_SSQ = WS_QLAT + (size_t)T * QL * 2;
constexpr size_t WS_ROPE = WS_SSQ + (size_t)2 * 16 * T * 4;
constexpr size_t WS_END = WS_ROPE + (size_t)2 * 2048 * 32 * 4;
static_assert(WS_O + (size_t)T * 1024 * 2 <= WS_H + SZ_H, "Q+O overlay");
static_assert(WS_CALL + (size_t)TALL * 256 * 2 <= WS_H + SZ_H, "latent overlay");
static_assert(WS_END <= (size_t)1 << 30, "workspace");

struct Params {
    const float* in[28];
    float* out;
    unsigned char* ws;
};

typedef __bf16 bf16x2_t __attribute__((ext_vector_type(2)));
__device__ __forceinline__ unsigned cvt_pk_bf16(float lo, float hi) { const f32x2 v = {lo, hi}; const bf16x2_t r = __builtin_convertvector(v, bf16x2_t); return __builtin_bit_cast(unsigned, r); }
__device__ __forceinline__ float bf2f(unsigned short b) { return __uint_as_float(((unsigned)b) << 16); }
__device__ __forceinline__ float bflo(unsigned w) { return __uint_as_float(w << 16); }
__device__ __forceinline__ float bfhi(unsigned w) { return __uint_as_float(w & 0xffff0000u); }
__device__ __forceinline__ float fast_rsqrt(float x) { return 1.0f / sqrtf(x); }
__device__ __forceinline__ float silu_mul(float g, float u) { return g * __builtin_amdgcn_rcpf(1.0f + __builtin_amdgcn_exp2f(-1.4426950408889634f * g)) * u; }

namespace pg8 {
constexpr int BM = 256, BK = 64, HALF = 128, HTB = HALF * BK * 2, STAGE_BYTES = 8 * HTB, NXCD = 8, WGM = 8;
__device__ __forceinline__ int lds_byte(int r, int c) { const int st = (r >> 4) * 2 + (c >> 5), rr = r & 15, cc = c & 31, ob = rr * 64 + cc * 2; return st * 1024 + (ob ^ (((ob >> 9) & 1) << 5)); }
__device__ __forceinline__ void stage_rc(int b, int& R, int& C) { const int st = b / 1024, sb = b % 1024, swz = sb ^ (((sb >> 9) & 1) << 5); R = (st >> 1) * 16 + swz / 64; C = (st & 1) * 32 + (swz % 64) / 2; }
__device__ __forceinline__ int perm32(int rho) { const int n = rho >> 4, i = rho & 15; return 8 * (i >> 2) + 4 * n + (i & 3); }

struct Unit { int pm, pn; };
struct Gemm { const bf16_t* A; const bf16_t* Bt; int lda, ldb, K, nM, nN; size_t a_pn_stride; };

struct StaticOrder {
    int nM, nN, nwg, G, c;
    __device__ void init(int nM_, int nN_, int G_, int c_) { nM = nM_; nN = nN_; nwg = nM * nN; G = G_; c = c_; }
    __device__ bool next(int i, Unit& u) const {
        const long L = (long)i * G + c; if (L >= nwg) return false;
        int wgid = (int)L; { const int q = nwg / NXCD, r = nwg % NXCD, xcd = wgid % NXCD, off = wgid / NXCD; wgid = (xcd < r ? xcd * (q + 1) : r * (q + 1) + (xcd - r) * q) + off; }
        const int nig = WGM * nN, gid = wgid / nig, fm = gid * WGM, gsz = (nM - fm) < WGM ? (nM - fm) : WGM;
        u.pm = fm + ((wgid % nig) % gsz); u.pn = (wgid % nig) / gsz; return true;
    }
};


__device__ __forceinline__ float row_rstd(const float* ssq, int row, int fq) {
    float s = 0.f;
#pragma unroll
    for (int j = 0; j < 4; ++j) s += ssq[(size_t)(4 * fq + j) * T + row];
    s += __shfl_xor(s, 16); s += __shfl_xor(s, 32);
    return fast_rsqrt(s * (1.0f / 1024.0f) + EPS);
}

struct EpiSwiglu {
    static constexpr bool PERM = true;
    bf16_t* H; const float* ssq;
    __device__ __forceinline__ void operator()(const f32x4 (&acc)[2][2][4][2], const Unit& u, int wr, int wc, int fr_, int fq_) const {
        int fr = fr_, fq = fq_; asm volatile("" : "+v"(fr), "+v"(fq));
        const int row0 = u.pm * BM + wr * 64 + fr;
#pragma unroll
        for (int ai = 0; ai < 2; ++ai)
#pragma unroll
            for (int m = 0; m < 4; ++m) {
                const int row = row0 + ai * HALF + m * 16;
                const float r = row_rstd(ssq, row, fq);
                const f32x4 g0 = acc[ai][0][m][0] * r, g1 = acc[ai][0][m][1] * r, u0 = acc[ai][1][m][0] * r, u1 = acc[ai][1][m][1] * r;
                u32x4 w;
                w.x = cvt_pk_bf16(silu_mul(g0[0], u0[0]), silu_mul(g0[1], u0[1]));
                w.y = cvt_pk_bf16(silu_mul(g0[2], u0[2]), silu_mul(g0[3], u0[3]));
                w.z = cvt_pk_bf16(silu_mul(g1[0], u1[0]), silu_mul(g1[1], u1[1]));
                w.w = cvt_pk_bf16(silu_mul(g1[2], u1[2]), silu_mul(g1[3], u1[3]));
                *(u32x4*)(H + (size_t)row * FF + u.pn * 128 + wc * 32 + 8 * fq) = w;
            }
    }
};

struct EpiResid {
    static constexpr bool PERM = false;
    const float* res0; const float* res1; float* out; bf16_t* xb; float* ssq; const float* colscale; float cs;
    __device__ __forceinline__ void operator()(const f32x4 (&acc)[2][2][4][2], const Unit& u, int wr, int wc, int fr_, int fq_) const {
        int fr = fr_, fq = fq_; asm volatile("" : "+v"(fr), "+v"(fq));
        const int row0 = u.pm * BM + wr * 64 + fr;
#pragma unroll
        for (int ai = 0; ai < 2; ++ai)
#pragma unroll
            for (int m = 0; m < 4; ++m) {
                const int row = row0 + ai * HALF + m * 16;
                const float* rp = (row < TP) ? res0 + (size_t)row * DM : res1 + (size_t)(row - TP) * DM;
                float sq = 0.f;
#pragma unroll
                for (int bj = 0; bj < 2; ++bj)
#pragma unroll
                    for (int n = 0; n < 2; ++n) {
                        const int col = u.pn * BM + bj * HALF + wc * 32 + n * 16 + 4 * fq;
                        const f32x4 rv = *(const f32x4*)(rp + col);
                        f32x4 sc = (f32x4){cs, cs, cs, cs};
                        if (colscale) sc = *(const f32x4*)(colscale + col);
                        const f32x4 v = rv + acc[ai][bj][m][n] * sc;
                        *(f32x4*)(out + (size_t)row * DM + col) = v;
                        u32x2 w; w.x = cvt_pk_bf16(v[0], v[1]); w.y = cvt_pk_bf16(v[2], v[3]);
                        *(u32x2*)(xb + (size_t)row * DM + col) = w;
                        sq += (v[0] * v[0] + v[1] * v[1]) + (v[2] * v[2] + v[3] * v[3]);
                    }
                sq += __shfl_xor(sq, 16); sq += __shfl_xor(sq, 32);
                if (fq == 0) ssq[(size_t)(u.pn * 4 + wc) * T + row] = sq;
            }
    }
};

struct EpiRawF32 {
    static constexpr bool PERM = false;
    float* O; int ldc; int ncols; const float* ssq;
    __device__ __forceinline__ void operator()(const f32x4 (&acc)[2][2][4][2], const Unit& u, int wr, int wc, int fr_, int fq_) const {
        int fr = fr_, fq = fq_; asm volatile("" : "+v"(fr), "+v"(fq));
        const int row0 = u.pm * BM + wr * 64 + fr;
#pragma unroll
        for (int ai = 0; ai < 2; ++ai)
#pragma unroll
            for (int m = 0; m < 4; ++m) {
                const int row = row0 + ai * HALF + m * 16;
                const float r = row_rstd(ssq, row, fq);
#pragma unroll
                for (int bj = 0; bj < 2; ++bj)
#pragma unroll
                    for (int n = 0; n < 2; ++n) {
                        const int col = u.pn * BM + bj * HALF + wc * 32 + n * 16 + 4 * fq;
                        if (col < ncols) *(f32x4*)(O + (size_t)row * ldc + col) = acc[ai][bj][m][n] * r;
                    }
            }
    }
};

struct EpiRawBf16 {
    static constexpr bool PERM = true;
    bf16_t* O; int ldc;
    __device__ __forceinline__ void operator()(const f32x4 (&acc)[2][2][4][2], const Unit& u, int wr, int wc, int fr_, int fq_) const {
        int fr = fr_, fq = fq_; asm volatile("" : "+v"(fr), "+v"(fq));
        const int row0 = u.pm * BM + wr * 64 + fr;
#pragma unroll
        for (int ai = 0; ai < 2; ++ai)
#pragma unroll
            for (int m = 0; m < 4; ++m) {
                bf16_t* rowp = O + (size_t)(row0 + ai * HALF + m * 16) * ldc + u.pn * BM + wc * 32 + 8 * fq;
#pragma unroll
                for (int bj = 0; bj < 2; ++bj) {
                    const f32x4 v0 = acc[ai][bj][m][0], v1 = acc[ai][bj][m][1];
                    u32x4 w; w.x = cvt_pk_bf16(v0[0], v0[1]); w.y = cvt_pk_bf16(v0[2], v0[3]); w.z = cvt_pk_bf16(v1[0], v1[1]); w.w = cvt_pk_bf16(v1[2], v1[3]);
                    *(u32x4*)(rowp + bj * HALF) = w;
                }
            }
    }
};

template <class Epi>
__device__ __forceinline__ void gemm_phase(LAS unsigned char* lds, const Gemm g, const StaticOrder& S, const Epi& E) {
    int tid = threadIdx.x; asm volatile("" : "+v"(tid));
    const int wid = __builtin_amdgcn_readfirstlane(tid >> 6), lane = tid & 63, wr = wid >> 2, wc = wid & 3, fr = lane & 15, fq = lane >> 4;
    const int K = g.K, nt = K / BK;
    unsigned voffA[2], voffB[2];
#pragma unroll
    for (int i = 0; i < 2; ++i) { int R, C; stage_rc(tid * 16 + i * 8192, R, C); const int Rb = Epi::PERM ? ((R & ~31) + perm32(R & 31)) : R;
        voffA[i] = (unsigned)(R * g.lda + C) * 2u; voffB[i] = (unsigned)(Rb * g.ldb + C) * 2u; }
    const size_t kstep = (size_t)(BK * 2);
    const size_t hA = (size_t)HALF * g.lda * 2, hB = (size_t)HALF * g.ldb * 2;
    const size_t tA = 2 * hA, tB = 2 * hB;
    const unsigned ldsw = (unsigned)wid * 1024u;
    const int aoff = lds_byte(wr * 64 + fr, fq * 8), boff = lds_byte(wc * 32 + fr, fq * 8);
#define PG8_SA(b, h) (((b) * 2 + (h)) * HTB)
#define PG8_SB(b, h) ((4 + (b) * 2 + (h)) * HTB)
#define PG8_STAGE(bufoff, gbase, voff) do { _Pragma("unroll") for (int _i = 0; _i < 2; ++_i) \
        __builtin_amdgcn_global_load_lds((const unsigned*)((const char*)(gbase) + (voff)[_i]), (LAS unsigned*)(lds + (bufoff) + ldsw + _i * 8192), 16, 0, 0); } while (0)
#define PG8_LDA(dst, b, h) do { _Pragma("unroll") for (int m = 0; m < 4; ++m) _Pragma("unroll") for (int k = 0; k < 2; ++k) dst[m][k] = *(const LAS bf16x8*)(lds + PG8_SA(b, h) + aoff + m * 2048 + k * 1024); } while (0)
#define PG8_LDB(dst, b, h) do { _Pragma("unroll") for (int n = 0; n < 2; ++n) _Pragma("unroll") for (int k = 0; k < 2; ++k) dst[n][k] = *(const LAS bf16x8*)(lds + PG8_SB(b, h) + boff + n * 2048 + k * 1024); } while (0)
#define PG8_MMA(ai, bj, At, Bt) do { __builtin_amdgcn_s_setprio(1); _Pragma("unroll") for (int m = 0; m < 4; ++m) _Pragma("unroll") for (int n = 0; n < 2; ++n) _Pragma("unroll") for (int k = 0; k < 2; ++k) \
        acc[ai][bj][m][n] = __builtin_amdgcn_mfma_f32_16x16x32_bf16(Bt[n][k], At[m][k], acc[ai][bj][m][n], 0, 0, 0); __builtin_amdgcn_s_setprio(0); } while (0)
#define PG8_WAIT_V(n) asm volatile("s_waitcnt vmcnt(" #n ")" ::: "memory")
#define PG8_WAIT_L(n) asm volatile("s_waitcnt lgkmcnt(" #n ")" ::: "memory")
#define PG8_BAR __builtin_amdgcn_s_barrier()
#define PG8_SCHED __builtin_amdgcn_sched_barrier(0)
    Unit cur, nxt; int ui = 0;
    if (!S.next(0, cur)) return;
    f32x4 acc[2][2][4][2];
#pragma unroll
    for (int a = 0; a < 2; ++a)
#pragma unroll
        for (int b = 0; b < 2; ++b)
#pragma unroll
            for (int m = 0; m < 4; ++m)
#pragma unroll
                for (int n = 0; n < 2; ++n) acc[a][b][m][n] = (f32x4){0.f, 0.f, 0.f, 0.f};
    bf16x8 At[4][2], B0[2][2], B1[2][2];
    const char* cA = (const char*)g.A + (size_t)cur.pm * tA + (size_t)cur.pn * g.a_pn_stride; const char* cB = (const char*)g.Bt + (size_t)cur.pn * tB;
    PG8_STAGE(PG8_SB(0, 0), cB, voffB); PG8_STAGE(PG8_SB(0, 1), cB + hB, voffB); PG8_STAGE(PG8_SA(0, 0), cA, voffA); PG8_STAGE(PG8_SA(0, 1), cA + hA, voffA);
    if (wr == 1) PG8_BAR;
    PG8_WAIT_V(2); PG8_BAR;
    PG8_STAGE(PG8_SB(1, 0), cB + kstep, voffB); PG8_STAGE(PG8_SA(1, 0), cA + kstep, voffA); PG8_STAGE(PG8_SB(1, 1), cB + hB + kstep, voffB);
    PG8_WAIT_V(6); PG8_BAR;
    for (;;) {
        const bool has_next = S.next(ui + 1, nxt);
        const char* nA = has_next ? (const char*)g.A + (size_t)nxt.pm * tA + (size_t)nxt.pn * g.a_pn_stride : cA; const char* nB = has_next ? (const char*)g.Bt + (size_t)nxt.pn * tB : cB;
        for (int t = 0; t < nt; t += 2) {
            const bool last = (t == nt - 2);
            const char* a1 = cA + (size_t)(t + 1) * kstep;
            const char* a2 = last ? nA : cA + (size_t)(t + 2) * kstep; const char* b2 = last ? nB : cB + (size_t)(t + 2) * kstep;
            const char* a3 = a2 + kstep; const char* b3 = b2 + kstep;
            PG8_LDB(B0, 0, 0); PG8_LDB(B1, 0, 1); PG8_SCHED; PG8_LDA(At, 0, 0); PG8_STAGE(PG8_SA(1, 1), a1 + hA, voffA);
            PG8_WAIT_V(8); PG8_WAIT_L(0); PG8_BAR; PG8_MMA(0, 0, At, B0); PG8_MMA(0, 1, At, B1); PG8_BAR; PG8_SCHED;
            PG8_LDA(At, 0, 1); PG8_STAGE(PG8_SB(0, 0), b2, voffB); PG8_STAGE(PG8_SB(0, 1), b2 + hB, voffB); PG8_STAGE(PG8_SA(0, 0), a2, voffA);
            PG8_WAIT_V(8); PG8_WAIT_L(0); PG8_BAR; PG8_MMA(1, 0, At, B0); PG8_MMA(1, 1, At, B1); PG8_BAR; PG8_SCHED;
            PG8_LDB(B0, 1, 0); PG8_LDB(B1, 1, 1); PG8_SCHED; PG8_LDA(At, 1, 0); PG8_STAGE(PG8_SA(0, 1), a2 + hA, voffA);
            PG8_WAIT_V(8); PG8_WAIT_L(0); PG8_BAR; PG8_MMA(0, 0, At, B0); PG8_MMA(0, 1, At, B1); PG8_BAR; PG8_SCHED;
            PG8_LDA(At, 1, 1); PG8_STAGE(PG8_SB(1, 0), b3, voffB); PG8_STAGE(PG8_SB(1, 1), b3 + hB, voffB); PG8_STAGE(PG8_SA(1, 0), a3, voffA);
            PG8_WAIT_V(8); PG8_WAIT_L(0); PG8_BAR; PG8_MMA(1, 0, At, B0); PG8_MMA(1, 1, At, B1); PG8_BAR; PG8_SCHED;
        }
        if (wr == 0) PG8_BAR;
        E(acc, cur, wr, wc, fr, fq);
        if (!has_next) break;
#pragma unroll
        for (int a = 0; a < 2; ++a)
#pragma unroll
            for (int b = 0; b < 2; ++b)
#pragma unroll
                for (int m = 0; m < 4; ++m)
#pragma unroll
                    for (int n = 0; n < 2; ++n) acc[a][b][m][n] = (f32x4){0.f, 0.f, 0.f, 0.f};
        cur = nxt; cA = nA; cB = nB; ++ui;
        if (wr == 1) PG8_BAR;
    }
    PG8_WAIT_V(0);
    PG8_BAR;
#undef PG8_SA
#undef PG8_SB
#undef PG8_STAGE
#undef PG8_LDA
#undef PG8_LDB
#undef PG8_MMA
#undef PG8_WAIT_V
#undef PG8_WAIT_L
#undef PG8_BAR
#undef PG8_SCHED
}
}

__device__ __forceinline__ float wave_sum(float v) {
#pragma unroll
    for (int o = 1; o < 64; o <<= 1) v += __shfl_xor(v, o);
    return v;
}
__device__ __forceinline__ void conv_weight(const float* W, int K, int N, bf16_t* WT, const float* gain, int mode, int row_off, LAS float* scr, int gw, int NGW, int lane) {
    const int nblk = N / 32, nitems = (K / 64) * nblk;
    for (int item = gw; item < nitems; item += NGW) {
        const int kb = item / nblk, nb = item % nblk, k0 = 64 * kb, n0 = 32 * nb;
#pragma unroll 8
        for (int i = 0; i < 32; ++i) { const int kk = 2 * i + (lane >> 5); float v = W[(size_t)(k0 + kk) * N + n0 + (lane & 31)]; if (gain) v *= gain[k0 + kk]; scr[kk * 33 + (lane & 31)] = v; }
        asm volatile("s_waitcnt lgkmcnt(0)" ::: "memory");
        const int c = lane & 7;
#pragma unroll
        for (int j = 0; j < 4; ++j) {
            const int n = (lane >> 3) + 8 * j; const LAS float* s = scr + (8 * c) * 33 + n;
            u32x4 o; o.x = cvt_pk_bf16(s[0 * 33], s[1 * 33]); o.y = cvt_pk_bf16(s[2 * 33], s[3 * 33]); o.z = cvt_pk_bf16(s[4 * 33], s[5 * 33]); o.w = cvt_pk_bf16(s[6 * 33], s[7 * 33]);
            const int na = n0 + n; int row;
            if (mode == 1) { const int up = na >= FF ? 1 : 0; const int jn = na - up * FF; row = 256 * (jn >> 7) + 128 * up + (jn & 127); }
            else row = row_off + na;
            *(u32x4*)(WT + (size_t)row * K + k0 + 8 * c) = o;
        }
        asm volatile("s_waitcnt lgkmcnt(0)" ::: "memory");
    }
}

__device__ __forceinline__ void phase0(const Params& p, LAS unsigned char* lds, int G, int c) {
    int tid = threadIdx.x; asm volatile("" : "+v"(tid));
    const int lane = tid & 63, wave = tid >> 6;
    LAS float* scr = (LAS float*)(lds + wave * 8704);
    const int gw = c * 8 + wave, NGW = G * 8;
    unsigned char* ws = p.ws;
    for (int l = 0; l < 4; ++l) {
        conv_weight(p.in[6] + (size_t)l * 1024 * 5632, 1024, 5632, (bf16_t*)(ws + WS_WIN + (size_t)(2 * l) * SZ_WIN), p.in[5] + l * 1024, 1, 0, scr, gw, NGW, lane);
        conv_weight(p.in[10] + (size_t)l * 1024 * 5632, 1024, 5632, (bf16_t*)(ws + WS_WIN + (size_t)(2 * l + 1) * SZ_WIN), p.in[9] + l * 1024, 1, 0, scr, gw, NGW, lane);
        conv_weight(p.in[7] + (size_t)l * 2816 * 1024, 2816, 1024, (bf16_t*)(ws + WS_WOUT + (size_t)(2 * l) * SZ_WOUT), nullptr, 0, 0, scr, gw, NGW, lane);
        conv_weight(p.in[11] + (size_t)l * 2816 * 1024, 2816, 1024, (bf16_t*)(ws + WS_WOUT + (size_t)(2 * l + 1) * SZ_WOUT), nullptr, 0, 0, scr, gw, NGW, lane);
    }
    for (int lg = 0; lg < 8; ++lg)
        conv_weight(p.in[12] + (size_t)lg * 65536, 256, 256, (bf16_t*)(ws + WS_WPOOL) + (size_t)(lg >> 2) * 1024 * 256, nullptr, 0, (lg & 3) * 256, scr, gw, NGW, lane);
    conv_weight(p.in[15], 1024, 256, (bf16_t*)(ws + WS_WDKV), p.in[14], 0, 0, scr, gw, NGW, lane);
    conv_weight(p.in[17], 1024, 64, (bf16_t*)(ws + WS_WDKV), p.in[14], 0, 256, scr, gw, NGW, lane);
    conv_weight(p.in[19], 256, 1024, (bf16_t*)(ws + WS_WUK), nullptr, 0, 0, scr, gw, NGW, lane);
    conv_weight(p.in[21], 256, 1024, (bf16_t*)(ws + WS_WUV), nullptr, 0, 0, scr, gw, NGW, lane);
    for (int i = 0; i < 2; ++i) {
        conv_weight(p.in[22] + (size_t)i * 1024 * 384, 1024, 384, (bf16_t*)(ws + WS_WDQ) + (size_t)i * 512 * 1024, p.in[8] + (2 + i) * 1024, 0, 0, scr, gw, NGW, lane);
        conv_weight(p.in[24] + (size_t)i * 384 * 1536, 384, 1536, (bf16_t*)(ws + WS_WUQ) + (size_t)i * 1536 * 384, p.in[23] + i * 384, 0, 0, scr, gw, NGW, lane);
        conv_weight(p.in[27] + (size_t)i * 1024 * 1024, 1024, 1024, (bf16_t*)(ws + WS_WO) + (size_t)i * 1024 * 1024, nullptr, 0, 0, scr, gw, NGW, lane);
    }
    {
        const int gt = c * NTHREADS + tid, NGT = G * NTHREADS;
        const u32x4 z = (u32x4){0u, 0u, 0u, 0u};
        u32x4* d0 = (u32x4*)((bf16_t*)(ws + WS_WDKV) + (size_t)320 * 1024);
        for (int i = gt; i < 192 * 1024 / 8; i += NGT) d0[i] = z;
        for (int q = 0; q < 2; ++q) { u32x4* d1 = (u32x4*)((bf16_t*)(ws + WS_WDQ) + (size_t)q * 512 * 1024 + (size_t)384 * 1024);
            for (int i = gt; i < 128 * 1024 / 8; i += NGT) d1[i] = z; }
        float* ct = (float*)(ws + WS_ROPE); float* st = ct + 2048 * 32;
        for (int i = gt; i < 2048 * 32; i += NGT) {
            const int pos = i >> 5, j = i & 31;
            const float inv = exp2f(-(float)j * 0.41524101186092029f);
            const float rev = (float)pos * inv * 0.15915494309189535f;
            const float fr = rev - floorf(rev);
            ct[i] = __builtin_amdgcn_cosf(fr); st[i] = __builtin_amdgcn_sinf(fr);
        }
    }
    {
        bf16_t* xb = (bf16_t*)(ws + WS_XB); float* ssq = (float*)(ws + WS_SSQ);
        for (int row = gw; row < T; row += NGW) {
            const float* xr = (row < TP) ? p.in[0] + (size_t)row * DM : p.in[1] + (size_t)(row - TP) * DM;
            float s = 0.f;
#pragma unroll
            for (int j = 0; j < 4; ++j) {
                const f32x4 v = *(const f32x4*)(xr + 4 * lane + 256 * j);
                s += (v[0] * v[0] + v[1] * v[1]) + (v[2] * v[2] + v[3] * v[3]);
                u32x2 w; w.x = cvt_pk_bf16(v[0], v[1]); w.y = cvt_pk_bf16(v[2], v[3]);
                *(u32x2*)(xb + (size_t)row * DM + 4 * lane + 256 * j) = w;
            }
            s = wave_sum(s);
            if (lane < 16) ssq[(size_t)lane * T + row] = (lane == 0) ? s : 0.f;
        }
    }
}

__device__ __forceinline__ void pool_prep(const Params& p, int layer, const float* ssq, LAS unsigned char* lds, int G, int c) {
    int tid = threadIdx.x; asm volatile("" : "+v"(tid));
    LAS float* lrs = (LAS float*)lds;
    const float* x = p.out;
    const float* gain = p.in[8] + layer * DM;
    bf16_t* Dp = (bf16_t*)(p.ws + WS_D);
    const int col = 2 * tid, grp = tid >> 7, w = 2 << grp;
    const f32x2 g2 = *(const f32x2*)(gain + col);
    for (int item = c; item < 2048 + 8; item += G) {
        const bool samp = item >= 2048;
        int b, s0, S, rowbase, start;
        if (!samp) { b = item >> 6; s0 = (item & 63) * 32; rowbase = b * SEQ; S = SEQ; start = 0; }
        else { b = item - 2048; s0 = 0; rowbase = TP + b * DSEQ; S = DSEQ; start = PAST; }
        if (tid < 47) {
            const int s = s0 - 15 + tid; float r = 0.f;
            if (s >= 0) { const int row = rowbase + s; float sum = 0.f;
#pragma unroll
                for (int j = 0; j < 16; ++j) sum += ssq[(size_t)j * T + row];
                r = fast_rsqrt(sum * (1.0f / 1024.0f) + EPS); }
            lrs[tid] = r;
        }
        __syncthreads();
        const float* prev = p.in[2] + ((size_t)(layer * DBATCH + b) * 15) * DM;
        auto hrow = [&](int s) -> f32x2 {
            if (s >= 0) { const f32x2 v = *(const f32x2*)(x + (size_t)(rowbase + s) * DM + col); const float r = lrs[s - s0 + 15]; return (f32x2){v.x * r * g2.x, v.y * r * g2.y}; }
            if (samp) return *(const f32x2*)(prev + (size_t)(15 + s) * DM + col);
            return (f32x2){0.f, 0.f};
        };
        f32x2 sum = (f32x2){0.f, 0.f};
        for (int j = 1; j < w; ++j) { const f32x2 h = hrow(s0 - j); sum += h; }
        float* opool = samp ? p.out + OUT_POOL_S + ((size_t)(layer * DBATCH + b) * 15) * DM : p.out + OUT_POOL_P + ((size_t)(layer * NBATCH + b) * 15) * DM;
        for (int s = s0; s < s0 + 32; ++s) {
            const f32x2 hs = hrow(s); sum += hs;
            const int pos = start + s; const int cnt = (pos + 1 < w) ? pos + 1 : w;
            const float ic = 1.0f / (float)cnt;
            const f32x2 d = (f32x2){sum.x * ic - hs.x, sum.y * ic - hs.y};
            *(unsigned*)(Dp + ((size_t)grp * T + rowbase + s) * 256 + (col & 255)) = cvt_pk_bf16(d.x, d.y);
            if (s >= S - 15) *(f32x2*)(opool + (size_t)(s - (S - 15)) * DM + col) = hs;
            const f32x2 ho = hrow(s - w + 1); sum -= ho;
        }
        __syncthreads();
    }
}

__device__ __forceinline__ void latent_norm(const Params& p, int G, int c) {
    int tid = threadIdx.x; asm volatile("" : "+v"(tid));
    const int lane = tid & 63, wave = tid >> 6;
    const int gw = c * 8 + wave, NGW = G * 8;
    const float* raw = (const float*)(p.ws + WS_LATRAW);
    bf16_t* call = (bf16_t*)(p.ws + WS_CALL); bf16_t* krb = (bf16_t*)(p.ws + WS_KR);
    const float* ct = (const float*)(p.ws + WS_ROPE); const float* st = ct + 2048 * 32;
    const f32x4 cg4 = *(const f32x4*)(p.in[16] + 4 * lane);
    const float kg = p.in[18][lane];
    for (int row = gw; row < T; row += NGW) {
        const float* rr = raw + (size_t)row * LATW;
        const f32x4 v = *(const f32x4*)(rr + 4 * lane);
        const float kv = rr[256 + lane];
        const float sc = wave_sum((v[0] * v[0] + v[1] * v[1]) + (v[2] * v[2] + v[3] * v[3]));
        const float sk = wave_sum(kv * kv);
        const float rc = fast_rsqrt(sc * (1.0f / 256.0f) + EPS), rk = fast_rsqrt(sk * (1.0f / 64.0f) + EPS);
        const f32x4 cv = (f32x4){v[0] * rc * cg4[0], v[1] * rc * cg4[1], v[2] * rc * cg4[2], v[3] * rc * cg4[3]};
        const float kn = kv * rk * kg;
        int pos, krow; float* oc; float* ok;
        if (row < TP) { pos = row & (SEQ - 1); krow = row; oc = p.out + OUT_CKV_P + (size_t)row * 256; ok = p.out + OUT_KR_P + (size_t)row * 64; }
        else { const int r2 = row - TP, b = r2 >> 5, s = r2 & 31; pos = PAST + s; krow = TP + b * SKEY + PAST + s; oc = p.out + OUT_CKV_S + (size_t)r2 * 256; ok = p.out + OUT_KR_S + (size_t)r2 * 64; }
        const float other = __shfl_xor(kn, 32);
        const float cs = ct[pos * 32 + (lane & 31)], sn = st[pos * 32 + (lane & 31)];
        const float ko = (lane < 32) ? (kn * cs - other * sn) : (kn * cs + other * sn);
        *(f32x4*)(oc + 4 * lane) = cv;
        ok[lane] = ko;
        u32x2 w; w.x = cvt_pk_bf16(cv[0], cv[1]); w.y = cvt_pk_bf16(cv[2], cv[3]);
        *(u32x2*)(call + (size_t)krow * 256 + 4 * lane) = w;
        const float kon = __shfl_down(ko, 1);
        if ((lane & 1) == 0) *(unsigned*)(krb + (size_t)krow * 64 + lane) = cvt_pk_bf16(ko, kon);
    }
    for (int r = gw; r < DBATCH * SKEY; r += NGW) {
        const int b = r / SKEY, t = r % SKEY; const int krow = TP + r;
        if (t >= PAST && t < PAST + DSEQ) continue;
        u32x2 w = (u32x2){0u, 0u}; unsigned kw = 0u;
        if (t < PAST) {
            const f32x4 v = *(const f32x4*)(p.in[3] + ((size_t)b * PAST + t) * 256 + 4 * lane);
            w.x = cvt_pk_bf16(v[0], v[1]); w.y = cvt_pk_bf16(v[2], v[3]);
            if (lane < 32) { const f32x2 k2 = *(const f32x2*)(p.in[4] + ((size_t)b * PAST + t) * 64 + 2 * lane); kw = cvt_pk_bf16(k2.x, k2.y); }
        }
        *(u32x2*)(call + (size_t)krow * 256 + 4 * lane) = w;
        if (lane < 32) *(unsigned*)(krb + (size_t)krow * 64 + 2 * lane) = kw;
    }
}

__device__ __forceinline__ void k_assemble(const Params& p, int G, int c) {
    int tid = threadIdx.x; asm volatile("" : "+v"(tid));
    const int lane = tid & 63, wave = tid >> 6;
    const int gw = c * 8 + wave, NGW = G * 8;
    bf16_t* kn = (bf16_t*)(p.ws + WS_KN);
    const float* g = p.in[20] + (lane & 7) * 16;
    float gg[16];
#pragma unroll
    for (int i = 0; i < 16; ++i) gg[i] = g[i];
    for (int row = gw; row < TALL; row += NGW) {
        u32x4* ptr = (u32x4*)(kn + (size_t)row * 1024 + lane * 16);
        const u32x4 a = ptr[0], b = ptr[1];
        float v[16];
        v[0] = bflo(a.x); v[1] = bfhi(a.x); v[2] = bflo(a.y); v[3] = bfhi(a.y); v[4] = bflo(a.z); v[5] = bfhi(a.z); v[6] = bflo(a.w); v[7] = bfhi(a.w);
        v[8] = bflo(b.x); v[9] = bfhi(b.x); v[10] = bflo(b.y); v[11] = bfhi(b.y); v[12] = bflo(b.z); v[13] = bfhi(b.z); v[14] = bflo(b.w); v[15] = bfhi(b.w);
        float s = 0.f;
#pragma unroll
        for (int i = 0; i < 16; ++i) s += v[i] * v[i];
        s += __shfl_xor(s, 1); s += __shfl_xor(s, 2); s += __shfl_xor(s, 4);
        const float r = fast_rsqrt(s * (1.0f / 128.0f) + EPS);
        u32x4 oa, ob;
        oa.x = cvt_pk_bf16(v[0] * r * gg[0], v[1] * r * gg[1]); oa.y = cvt_pk_bf16(v[2] * r * gg[2], v[3] * r * gg[3]);
        oa.z = cvt_pk_bf16(v[4] * r * gg[4], v[5] * r * gg[5]); oa.w = cvt_pk_bf16(v[6] * r * gg[6], v[7] * r * gg[7]);
        ob.x = cvt_pk_bf16(v[8] * r * gg[8], v[9] * r * gg[9]); ob.y = cvt_pk_bf16(v[10] * r * gg[10], v[11] * r * gg[11]);
        ob.z = cvt_pk_bf16(v[12] * r * gg[12], v[13] * r * gg[13]); ob.w = cvt_pk_bf16(v[14] * r * gg[14], v[15] * r * gg[15]);
        ptr[0] = oa; ptr[1] = ob;
    }
}

__device__ __forceinline__ void qlat_norm(const Params& p, int G, int c) {
    int tid = threadIdx.x; asm volatile("" : "+v"(tid));
    const int lane = tid & 63, wave = tid >> 6;
    const int gw = c * 8 + wave, NGW = G * 8;
    const float* raw = (const float*)(p.ws + WS_DQRAW); bf16_t* ql = (bf16_t*)(p.ws + WS_QLAT);
    for (int row = gw; row < T; row += NGW) {
        const float* rr = raw + (size_t)row * QL;
        f32x2 v[3]; float s = 0.f;
#pragma unroll
        for (int j = 0; j < 3; ++j) { v[j] = *(const f32x2*)(rr + 2 * lane + 128 * j); s += v[j].x * v[j].x + v[j].y * v[j].y; }
        s = wave_sum(s);
        const float r = fast_rsqrt(s * (1.0f / 384.0f) + EPS);
#pragma unroll
        for (int j = 0; j < 3; ++j) *(unsigned*)(ql + (size_t)row * QL + 2 * lane + 128 * j) = cvt_pk_bf16(v[j].x * r, v[j].y * r);
    }
}

__device__ __forceinline__ void q_assemble(const Params& p, int i, int G, int c) {
    int tid = threadIdx.x; asm volatile("" : "+v"(tid));
    const int lane = tid & 63, wave = tid >> 6;
    const int gw = c * 8 + wave, NGW = G * 8;
    bf16_t* Q = (bf16_t*)(p.ws + WS_Q);
    const float* ct = (const float*)(p.ws + WS_ROPE); const float* st = ct + 2048 * 32;
    const int head = lane >> 3, sub = lane & 7;
    const float SC = 0.07216878364870323f * 1.4426950408889634f;
    float gn[16], gr[8];
#pragma unroll
    for (int j = 0; j < 16; ++j) gn[j] = p.in[25][i * 128 + sub * 16 + j] * SC;
#pragma unroll
    for (int j = 0; j < 8; ++j) gr[j] = p.in[26][i * 64 + sub * 8 + j];
    for (int row = gw; row < T; row += NGW) {
        const int pos = (row < TP) ? (row & (SEQ - 1)) : (PAST + ((row - TP) & 31));
        bf16_t* qh = Q + (size_t)row * HQ + head * 192;
        u32x4* pn = (u32x4*)(qh + sub * 16); u32x4* pr = (u32x4*)(qh + 128 + sub * 8);
        const u32x4 a = pn[0], b = pn[1], rw = pr[0];
        float v[16], rv[8];
        v[0] = bflo(a.x); v[1] = bfhi(a.x); v[2] = bflo(a.y); v[3] = bfhi(a.y); v[4] = bflo(a.z); v[5] = bfhi(a.z); v[6] = bflo(a.w); v[7] = bfhi(a.w);
        v[8] = bflo(b.x); v[9] = bfhi(b.x); v[10] = bflo(b.y); v[11] = bfhi(b.y); v[12] = bflo(b.z); v[13] = bfhi(b.z); v[14] = bflo(b.w); v[15] = bfhi(b.w);
        rv[0] = bflo(rw.x); rv[1] = bfhi(rw.x); rv[2] = bflo(rw.y); rv[3] = bfhi(rw.y); rv[4] = bflo(rw.z); rv[5] = bfhi(rw.z); rv[6] = bflo(rw.w); rv[7] = bfhi(rw.w);
        float s = 0.f, s2 = 0.f;
#pragma unroll
        for (int j = 0; j < 16; ++j) s += v[j] * v[j];
#pragma unroll
        for (int j = 0; j < 8; ++j) s2 += rv[j] * rv[j];
        s += __shfl_xor(s, 1); s += __shfl_xor(s, 2); s += __shfl_xor(s, 4);
        s2 += __shfl_xor(s2, 1); s2 += __shfl_xor(s2, 2); s2 += __shfl_xor(s2, 4);
        const float rn = fast_rsqrt(s * (1.0f / 128.0f) + EPS), rr = fast_rsqrt(s2 * (1.0f / 64.0f) + EPS);
        u32x4 oa, ob;
        oa.x = cvt_pk_bf16(v[0] * rn * gn[0], v[1] * rn * gn[1]); oa.y = cvt_pk_bf16(v[2] * rn * gn[2], v[3] * rn * gn[3]);
        oa.z = cvt_pk_bf16(v[4] * rn * gn[4], v[5] * rn * gn[5]); oa.w = cvt_pk_bf16(v[6] * rn * gn[6], v[7] * rn * gn[7]);
        ob.x = cvt_pk_bf16(v[8] * rn * gn[8], v[9] * rn * gn[9]); ob.y = cvt_pk_bf16(v[10] * rn * gn[10], v[11] * rn * gn[11]);
        ob.z = cvt_pk_bf16(v[12] * rn * gn[12], v[13] * rn * gn[13]); ob.w = cvt_pk_bf16(v[14] * rn * gn[14], v[15] * rn * gn[15]);
        pn[0] = oa; pn[1] = ob;
        float o[8];
        const int jb = (sub & 3) * 8;
#pragma unroll
        for (int j = 0; j < 8; ++j) {
            const float me = rv[j] * rr * gr[j];
            const float other = __shfl_xor(me, 4);
            const float cs = ct[pos * 32 + jb + j], sn = st[pos * 32 + jb + j];
            o[j] = ((sub < 4) ? (me * cs - other * sn) : (me * cs + other * sn)) * SC;
        }
        u32x4 orr; orr.x = cvt_pk_bf16(o[0], o[1]); orr.y = cvt_pk_bf16(o[2], o[3]); orr.z = cvt_pk_bf16(o[4], o[5]); orr.w = cvt_pk_bf16(o[6], o[7]);
        pr[0] = orr;
    }
}

#define MFMA32(a, b, c) __builtin_amdgcn_mfma_f32_32x32x16_bf16((a), (b), (c), 0, 0, 0)
constexpr int KSTR = 400, VSTR = 144, KBUF = 64 * KSTR, VBUF = 128 * VSTR, ABUF = KBUF + VBUF;
__device__ __forceinline__ void attn_phase(const Params& p, LAS unsigned char* lds, int G, int c) {
    int tid = threadIdx.x; asm volatile("" : "+v"(tid));
    const int wid = __builtin_amdgcn_readfirstlane(tid >> 6), lane = tid & 63, l32 = lane & 31, hi = lane >> 5;
    const bf16_t* Q = (const bf16_t*)(p.ws + WS_Q); const bf16_t* KN = (const bf16_t*)(p.ws + WS_KN); const bf16_t* KR = (const bf16_t*)(p.ws + WS_KR);
    const bf16_t* VT = (const bf16_t*)(p.ws + WS_VT); bf16_t* O = (bf16_t*)(p.ws + WS_O);
    for (int idx = c; idx < 2048 + 64; idx += G) {
        int h, qrow0, krow0, ntiles, wave_last; bool partial;
        if (idx < 2048) { const int bh = idx & 255, r = idx >> 8, qblk = (r & 1) ? (r >> 1) : 7 - (r >> 1), b = bh >> 3; h = bh & 7;
            qrow0 = b * SEQ + qblk * 256; krow0 = b * SEQ; ntiles = 4 * qblk + 4; wave_last = 4 * qblk + (wid >> 1); partial = false; }
        else { const int s = idx - 2048, b = s >> 3; h = s & 7; qrow0 = TP + b * DSEQ; krow0 = TP + b * SKEY; ntiles = 17; wave_last = (wid == 0) ? 16 : -1; partial = true; }
        const bool active = wave_last >= 0;
        bf16x8 qf[12];
        if (active) {
            const bf16_t* qp = Q + (size_t)(qrow0 + wid * 32 + l32) * HQ + h * 192 + hi * 8;
#pragma unroll
            for (int kk = 0; kk < 12; ++kk) qf[kk] = *(const bf16x8*)(qp + kk * 16);
        } else {
#pragma unroll
            for (int kk = 0; kk < 12; ++kk) qf[kk] = (bf16x8){0, 0, 0, 0, 0, 0, 0, 0};
        }
        f32x16 o[4];
#pragma unroll
        for (int d = 0; d < 4; ++d)
#pragma unroll
            for (int r = 0; r < 16; ++r) o[d][r] = 0.f;
        float mrun = -INFINITY, lsum = 0.f;
        const int kp0 = tid, kp1 = tid + 512;
        const int rk = tid >> 3, rc = tid & 7;
        const int vp0 = tid, vp1 = tid + 512;
        const bf16_t* gk0 = KN + (size_t)(krow0 + (kp0 >> 4)) * 1024 + h * 128 + (kp0 & 15) * 8;
        const bf16_t* gk1 = KN + (size_t)(krow0 + (kp1 >> 4)) * 1024 + h * 128 + (kp1 & 15) * 8;
        const bf16_t* gr = KR + (size_t)(krow0 + rk) * 64 + rc * 8;
        const bf16_t* gv0 = VT + (size_t)(h * 128 + (vp0 >> 3)) * TALL + krow0 + (vp0 & 7) * 8;
        const bf16_t* gv1 = VT + (size_t)(h * 128 + (vp1 >> 3)) * TALL + krow0 + (vp1 & 7) * 8;
        const int lk0 = (kp0 >> 4) * KSTR + (kp0 & 15) * 16, lk1 = (kp1 >> 4) * KSTR + (kp1 & 15) * 16, lr = rk * KSTR + 256 + rc * 16;
        const int lv0 = KBUF + (vp0 >> 3) * VSTR + ((vp0 & 7) >> 1) * 32 + 8 * (vp0 & 1);
        const int lv1 = KBUF + (vp1 >> 3) * VSTR + ((vp1 & 7) >> 1) * 32 + 8 * (vp1 & 1);
        u32x4 sk0, sk1, sr, sv0, sv1;
#define ATT_LOAD(t) do { sk0 = *(const u32x4*)(gk0 + (size_t)(t) * 64 * 1024); sk1 = *(const u32x4*)(gk1 + (size_t)(t) * 64 * 1024); sr = *(const u32x4*)(gr + (size_t)(t) * 64 * 64); \
                         sv0 = *(const u32x4*)(gv0 + (t) * 64); sv1 = *(const u32x4*)(gv1 + (t) * 64); } while (0)
#define ATT_WRITE(bufp) do { LAS unsigned char* _b = (bufp); *(LAS u32x4*)(_b + lk0) = sk0; *(LAS u32x4*)(_b + lk1) = sk1; *(LAS u32x4*)(_b + lr) = sr; \
                         *(LAS u32x2*)(_b + lv0) = (u32x2){sv0.x, sv0.y}; *(LAS u32x2*)(_b + lv0 + 16) = (u32x2){sv0.z, sv0.w}; \
                         *(LAS u32x2*)(_b + lv1) = (u32x2){sv1.x, sv1.y}; *(LAS u32x2*)(_b + lv1 + 16) = (u32x2){sv1.z, sv1.w}; } while (0)
        ATT_LOAD(0);
        ATT_WRITE(lds);
        __syncthreads();
        for (int t = 0; t < ntiles; ++t) {
            LAS unsigned char* buf = lds + (t & 1) * ABUF;
            if (t + 1 < ntiles) ATT_LOAD(t + 1);
            if (t <= wave_last) {
                f32x16 s0, s1;
#pragma unroll
                for (int r = 0; r < 16; ++r) { s0[r] = 0.f; s1[r] = 0.f; }
                const LAS unsigned char* kb = buf + l32 * KSTR + hi * 16;
#pragma unroll
                for (int kk = 0; kk < 12; ++kk) {
                    const bf16x8 a0 = *(const LAS bf16x8*)(kb + kk * 32);
                    const bf16x8 a1 = *(const LAS bf16x8*)(kb + 32 * KSTR + kk * 32);
                    s0 = MFMA32(a0, qf[kk], s0);
                    s1 = MFMA32(a1, qf[kk], s1);
                }
                if (partial && t == ntiles - 1) {
#pragma unroll
                    for (int r = 0; r < 16; ++r) s1[r] = -INFINITY;
                }
                float mx = s0[0];
#pragma unroll
                for (int r = 1; r < 16; ++r) mx = fmaxf(mx, s0[r]);
#pragma unroll
                for (int r = 0; r < 16; ++r) mx = fmaxf(mx, s1[r]);
                mx = fmaxf(mx, __shfl_xor(mx, 32));
                const float mnew = fmaxf(mrun, mx);
                const float alpha = __builtin_amdgcn_exp2f(mrun - mnew);
                mrun = mnew;
                float rs = 0.f;
#pragma unroll
                for (int r = 0; r < 16; ++r) { s0[r] = __builtin_amdgcn_exp2f(s0[r] - mnew); s1[r] = __builtin_amdgcn_exp2f(s1[r] - mnew); rs += s0[r] + s1[r]; }
                lsum = lsum * alpha + rs;
#pragma unroll
                for (int d = 0; d < 4; ++d)
#pragma unroll
                    for (int r = 0; r < 16; ++r) o[d][r] *= alpha;
                bf16x8 pf[4];
                {
                    u32x4 w;
                    w.x = cvt_pk_bf16(s0[0], s0[1]); w.y = cvt_pk_bf16(s0[2], s0[3]); w.z = cvt_pk_bf16(s0[4], s0[5]); w.w = cvt_pk_bf16(s0[6], s0[7]); pf[0] = __builtin_bit_cast(bf16x8, w);
                    w.x = cvt_pk_bf16(s0[8], s0[9]); w.y = cvt_pk_bf16(s0[10], s0[11]); w.z = cvt_pk_bf16(s0[12], s0[13]); w.w = cvt_pk_bf16(s0[14], s0[15]); pf[1] = __builtin_bit_cast(bf16x8, w);
                    w.x = cvt_pk_bf16(s1[0], s1[1]); w.y = cvt_pk_bf16(s1[2], s1[3]); w.z = cvt_pk_bf16(s1[4], s1[5]); w.w = cvt_pk_bf16(s1[6], s1[7]); pf[2] = __builtin_bit_cast(bf16x8, w);
                    w.x = cvt_pk_bf16(s1[8], s1[9]); w.y = cvt_pk_bf16(s1[10], s1[11]); w.z = cvt_pk_bf16(s1[12], s1[13]); w.w = cvt_pk_bf16(s1[14], s1[15]); pf[3] = __builtin_bit_cast(bf16x8, w);
                }
                const LAS unsigned char* vb = buf + KBUF + l32 * VSTR + hi * 16;
#pragma unroll
                for (int d = 0; d < 4; ++d)
#pragma unroll
                    for (int ks = 0; ks < 4; ++ks) {
                        const bf16x8 vf = *(const LAS bf16x8*)(vb + d * 32 * VSTR + ks * 32);
                        o[d] = MFMA32(vf, pf[ks], o[d]);
                    }
            }
            if (t + 1 < ntiles) ATT_WRITE(lds + ((t + 1) & 1) * ABUF);
            __syncthreads();
        }
        if (active) {
            const float l = lsum + __shfl_xor(lsum, 32);
            const float inv = 1.0f / l;
            bf16_t* op = O + (size_t)(qrow0 + wid * 32 + l32) * DM + h * 128 + 4 * hi;
#pragma unroll
            for (int d = 0; d < 4; ++d)
#pragma unroll
                for (int g4 = 0; g4 < 4; ++g4) {
                    u32x2 w; w.x = cvt_pk_bf16(o[d][4 * g4] * inv, o[d][4 * g4 + 1] * inv); w.y = cvt_pk_bf16(o[d][4 * g4 + 2] * inv, o[d][4 * g4 + 3] * inv);
                    *(u32x2*)(op + d * 32 + 8 * g4) = w;
                }
        }
#undef ATT_LOAD
#undef ATT_WRITE
    }
}

__global__ void __launch_bounds__(NTHREADS, 2) yoco_fwd(Params p) {
    extern __shared__ __attribute__((aligned(16))) unsigned char lds_raw[];
    LAS unsigned char* lds = (LAS unsigned char*)lds_raw;
    cg::grid_group grid = cg::this_grid();
    const int G = gridDim.x, c = blockIdx.x;
    unsigned char* ws = p.ws;
    bf16_t* xb = (bf16_t*)(ws + WS_XB); bf16_t* Hb = (bf16_t*)(ws + WS_H);
    float* ssqb = (float*)(ws + WS_SSQ);
    float* xo = p.out;
    int cur = 0;

#ifndef NO_P0
    phase0(p, lds, G, c);
#endif
    grid.sync();

    for (int l = 0; l < 4; ++l) {
        for (int hf = 0; hf < 2; ++hf) {
            if (hf == 1) {
                if (l < 2) {
#ifndef NO_PP
                    pool_prep(p, l, ssqb + (size_t)cur * 16 * T, lds, G, c);
#endif
                    grid.sync();
                    {
                        pg8::Gemm g{(const bf16_t*)(ws + WS_D), (const bf16_t*)(ws + WS_WPOOL) + (size_t)l * 1024 * 256, 256, 256, 256, T / 256, 4, (size_t)T * 256 * 2};
                        pg8::StaticOrder S; S.init(T / 256, 4, G, c);
                        pg8::EpiResid E{xo, xo + (size_t)TP * DM, xo, xb, ssqb + (size_t)(cur ^ 1) * 16 * T, p.in[13] + l * DM, 1.0f};
#ifndef NO_EPIRESID
                        pg8::gemm_phase<pg8::EpiResid>(lds, g, S, E);
#endif
                    }
                    cur ^= 1;
                    grid.sync();
                } else {
                    const int i = l - 2;
                    {
                        pg8::Gemm g{xb, (const bf16_t*)(ws + WS_WDQ) + (size_t)i * 512 * 1024, 1024, 1024, 1024, T / 256, 2, 0};
                        pg8::StaticOrder S; S.init(T / 256, 2, G, c);
                        pg8::EpiRawF32 E{(float*)(ws + WS_DQRAW), QL, QL, ssqb + (size_t)cur * 16 * T};
#ifndef NO_EPIRAWF32
                        pg8::gemm_phase<pg8::EpiRawF32>(lds, g, S, E);
#endif
                    }
                    grid.sync();
#ifndef NO_EW
                    qlat_norm(p, G, c);
#endif
                    grid.sync();
                    {
                        pg8::Gemm g{(const bf16_t*)(ws + WS_QLAT), (const bf16_t*)(ws + WS_WUQ) + (size_t)i * 1536 * 384, 384, 384, 384, T / 256, 6, 0};
                        pg8::StaticOrder S; S.init(T / 256, 6, G, c);
                        pg8::EpiRawBf16 E{(bf16_t*)(ws + WS_Q), HQ};
#ifndef NO_EPIRAWBF16
                        pg8::gemm_phase<pg8::EpiRawBf16>(lds, g, S, E);
#endif
                    }
                    grid.sync();
#ifndef NO_QA
                    q_assemble(p, i, G, c);
#endif
                    grid.sync();
#ifndef NO_ATT
                    attn_phase(p, lds, G, c);
#endif
                    grid.sync();
                    {
                        pg8::Gemm g{(const bf16_t*)(ws + WS_O), (const bf16_t*)(ws + WS_WO) + (size_t)i * 1024 * 1024, 1024, 1024, 1024, T / 256, 4, 0};
                        pg8::StaticOrder S; S.init(T / 256, 4, G, c);
                        pg8::EpiResid E{xo, xo + (size_t)TP * DM, xo, xb, ssqb + (size_t)(cur ^ 1) * 16 * T, nullptr, 1.0f};
#ifndef NO_EPIRESID
                        pg8::gemm_phase<pg8::EpiResid>(lds, g, S, E);
#endif
                    }
                    cur ^= 1;
                    grid.sync();
                }
            }
            {
                pg8::Gemm g{xb, (const bf16_t*)(ws + WS_WIN + (size_t)(2 * l + hf) * SZ_WIN), 1024, 1024, 1024, T / 256, 22, 0};
                pg8::StaticOrder S; S.init(T / 256, 22, G, c);
                pg8::EpiSwiglu E{Hb, ssqb + (size_t)cur * 16 * T};
#ifndef NO_EPISWIGLU
                pg8::gemm_phase<pg8::EpiSwiglu>(lds, g, S, E);
#endif
            }
            grid.sync();
            {
                pg8::Gemm g{Hb, (const bf16_t*)(ws + WS_WOUT + (size_t)(2 * l + hf) * SZ_WOUT), FF, FF, FF, T / 256, 4, 0};
                pg8::StaticOrder S; S.init(T / 256, 4, G, c);
                const bool first = (l == 0 && hf == 0);
                pg8::EpiResid E{first ? p.in[0] : xo, first ? p.in[1] : xo + (size_t)TP * DM, xo, xb, ssqb + (size_t)(cur ^ 1) * 16 * T, nullptr, 0.5f};
#ifndef NO_EPIRESID
                pg8::gemm_phase<pg8::EpiResid>(lds, g, S, E);
#endif
            }
            cur ^= 1;
            grid.sync();
        }
        if (l == 1) {
            {
                pg8::Gemm g{xb, (const bf16_t*)(ws + WS_WDKV), 1024, 1024, 1024, T / 256, 2, 0};
                pg8::StaticOrder S; S.init(T / 256, 2, G, c);
                pg8::EpiRawF32 E{(float*)(ws + WS_LATRAW), LATW, LATW, ssqb + (size_t)cur * 16 * T};
#ifndef NO_EPIRAWF32
                pg8::gemm_phase<pg8::EpiRawF32>(lds, g, S, E);
#endif
            }
            grid.sync();
#ifndef NO_EW
            latent_norm(p, G, c);
#endif
            grid.sync();
            {
                pg8::Gemm g{(const bf16_t*)(ws + WS_CALL), (const bf16_t*)(ws + WS_WUK), 256, 256, 256, TALL / 256, 4, 0};
                pg8::StaticOrder S; S.init(TALL / 256, 4, G, c);
                pg8::EpiRawBf16 E{(bf16_t*)(ws + WS_KN), 1024};
#ifndef NO_EPIRAWBF16
                pg8::gemm_phase<pg8::EpiRawBf16>(lds, g, S, E);
#endif
            }
            {
                pg8::Gemm g{(const bf16_t*)(ws + WS_WUV), (const bf16_t*)(ws + WS_CALL), 256, 256, 256, 4, TALL / 256, 0};
                pg8::StaticOrder S; S.init(4, TALL / 256, G, c);
                pg8::EpiRawBf16 E{(bf16_t*)(ws + WS_VT), TALL};
#ifndef NO_EPIRAWBF16
                pg8::gemm_phase<pg8::EpiRawBf16>(lds, g, S, E);
#endif
            }
            grid.sync();
#ifndef NO_KA
            k_assemble(p, G, c);
#endif
            grid.sync();
        }
    }
}

extern "C" void kernel_launch(void* const* d_in, const int* in_sizes, int n_in, void* d_out, int out_size, void* d_ws, size_t ws_size, hipStream_t stream) {
    static int grid_blocks = 0;
    if (grid_blocks == 0) {
        if (n_in != 28 || ws_size < WS_END) { fprintf(stderr, "kernel_launch: unexpected n_in %d or ws_size %zu (need %zu)\n", n_in, ws_size, (size_t)WS_END); }
        int dev = 0, cus = 0, per_cu = 0;
        hipGetDevice(&dev);
        hipDeviceGetAttribute(&cus, hipDeviceAttributeMultiprocessorCount, dev);
        if (hipFuncSetAttribute((const void*)yoco_fwd, hipFuncAttributeMaxDynamicSharedMemorySize, LDS_BYTES) != hipSuccess) fprintf(stderr, "kernel_launch: hipFuncSetAttribute failed\n");
        if (hipOccupancyMaxActiveBlocksPerMultiprocessor(&per_cu, (const void*)yoco_fwd, NTHREADS, LDS_BYTES) != hipSuccess || per_cu < 1) { fprintf(stderr, "kernel_launch: occupancy query gave %d\n", per_cu); per_cu = 1; }
        (void)hipGetLastError();
        grid_blocks = cus * 1;
        if (grid_blocks <= 0) grid_blocks = 256;
    }
    Params p{};
    for (int i = 0; i < 28; ++i) p.in[i] = (const float*)d_in[i];
    p.out = (float*)d_out; p.ws = (unsigned char*)d_ws;
    void* args[] = {&p};
    hipError_t e = hipLaunchCooperativeKernel((const void*)yoco_fwd, dim3(grid_blocks), dim3(NTHREADS), args, LDS_BYTES, stream);
    if (e != hipSuccess) fprintf(stderr, "cooperative launch failed: %s (grid %d)\n", hipGetErrorString(e), grid_blocks);
}
```

```cpp
#include <hip/hip_runtime.h>
#include <hip/hip_cooperative_groups.h>
#include <cstdio>
#include <cstdint>
namespace cg = cooperative_groups;

#define LAS __attribute__((address_space(3)))
#ifndef DUP_FFNIN
#define DUP_FFNIN 1
#endif
#ifndef DUP_ATT
#define DUP_ATT 1
#endif
#ifndef DUP_P0
#define DUP_P0 1
#endif
typedef unsigned short bf16_t;
typedef short bf16x8 __attribute__((ext_vector_type(8)));
typedef float f32x4 __attribute__((ext_vector_type(4)));
typedef float f32x2 __attribute__((ext_vector_type(2)));
typedef float f32x16 __attribute__((ext_vector_type(16)));
typedef unsigned u32x4 __attribute__((ext_vector_type(4)));
typedef unsigned u32x2 __attribute__((ext_vector_type(2)));

constexpr int DM = 1024, FF = 2816, TP = 65536, TS = 256, T = TP + TS, SEQ = 2048, NBATCH = 32, DBATCH = 8, DSEQ = 32, PAST = 1024;
constexpr int SKEY = 1088;
constexpr int TALL = TP + DBATCH * SKEY;
constexpr int KVL = 256, QL = 384, HQ = 1536, NH = 8, LATW = 320;
constexpr float EPS = 1e-6f;
constexpr int NTHREADS = 512;
constexpr int LDS_BYTES = 131072 + 1024;

constexpr size_t OUT_Y = 0;
constexpr size_t OUT_POOL_P = (size_t)T * DM;
constexpr size_t OUT_POOL_S = OUT_POOL_P + (size_t)2 * 32 * 15 * 1024;
constexpr size_t OUT_CKV_P = OUT_POOL_S + (size_t)2 * 8 * 15 * 1024;
constexpr size_t OUT_KR_P = OUT_CKV_P + (size_t)TP * 256;
constexpr size_t OUT_CKV_S = OUT_KR_P + (size_t)TP * 64;
constexpr size_t OUT_KR_S = OUT_CKV_S + (size_t)TS * 256;

constexpr size_t SZ_WIN = (size_t)5632 * 1024 * 2, SZ_WOUT = (size_t)1024 * 2816 * 2;
constexpr size_t WS_WIN = 0;
constexpr size_t WS_WOUT = WS_WIN + 8 * SZ_WIN;
constexpr size_t WS_WPOOL = WS_WOUT + 8 * SZ_WOUT;
constexpr size_t WS_WDKV = WS_WPOOL + (size_t)2 * 1024 * 256 * 2;
constexpr size_t WS_WUK = WS_WDKV + (size_t)512 * 1024 * 2;
constexpr size_t WS_WUV = WS_WUK + (size_t)1024 * 256 * 2;
constexpr size_t WS_WDQ = WS_WUV + (size_t)1024 * 256 * 2;
constexpr size_t WS_WUQ = WS_WDQ + (size_t)2 * 512 * 1024 * 2;
constexpr size_t WS_WO = WS_WUQ + (size_t)2 * 1536 * 384 * 2;
constexpr size_t WS_XB = WS_WO + (size_t)2 * 1024 * 1024 * 2;
constexpr size_t WS_H = WS_XB + (size_t)T * 1024 * 2;
constexpr size_t SZ_H = (size_t)T * FF * 2;
constexpr size_t WS_D = WS_H;
constexpr size_t WS_LATRAW = WS_H;
constexpr size_t WS_CALL = WS_H + (size_t)T * LATW * 4;
constexpr size_t WS_Q = WS_H;
constexpr size_t WS_O = WS_H + (size_t)T * HQ * 2;
constexpr size_t WS_DQRAW = WS_O;
constexpr size_t WS_KN = WS_H + SZ_H;
constexpr size_t WS_VT = WS_KN + (size_t)TALL * 1024 * 2;
constexpr size_t WS_KR = WS_VT + (size_t)TALL * 1024 * 2;
constexpr size_t WS_QLAT = WS_KR + (size_t)TALL * 64 * 2;
constexpr size_t WS_SSQ = WS_QLAT + (size_t)T * QL * 2;
constexpr size_t WS_ROPE = WS_SSQ + (size_t)2 * 16 * T * 4;
constexpr size_t WS_END = WS_ROPE + (size_t)2 * 2048 * 32 * 4;
static_assert(WS_O + (size_t)T * 1024 * 2 <= WS_H + SZ_H, "Q+O overlay");
static_assert(WS_CALL + (size_t)TALL * 256 * 2 <= WS_H + SZ_H, "latent overlay");
static_assert(WS_END <= (size_t)1 << 30, "workspace");

struct Params {
    const float* in[28];
    float* out;
    unsigned char* ws;
};

typedef __bf16 bf16x2_t __attribute__((ext_vector_type(2)));
__device__ __forceinline__ unsigned cvt_pk_bf16(float lo, float hi) { const f32x2 v = {lo, hi}; const bf16x2_t r = __builtin_convertvector(v, bf16x2_t); return __builtin_bit_cast(unsigned, r); }
__device__ __forceinline__ float bf2f(unsigned short b) { return __uint_as_float(((unsigned)b) << 16); }
__device__ __forceinline__ float bflo(unsigned w) { return __uint_as_float(w << 16); }
__device__ __forceinline__ float bfhi(unsigned w) { return __uint_as_float(w & 0xffff0000u); }
__device__ __forceinline__ float fast_rsqrt(float x) { return 1.0f / sqrtf(x); }
__device__ __forceinline__ float silu_mul(float g, float u) { return g * __builtin_amdgcn_rcpf(1.0f + __builtin_amdgcn_exp2f(-1.4426950408889634f * g)) * u; }

namespace pg8 {
constexpr int BM = 256, BK = 64, HALF = 128, HTB = HALF * BK * 2, STAGE_BYTES = 8 * HTB, NXCD = 8, WGM = 8;
__device__ __forceinline__ int lds_byte(int r, int c) { const int st = (r >> 4) * 2 + (c >> 5), rr = r & 15, cc = c & 31, ob = rr * 64 + cc * 2; return st * 1024 + (ob ^ (((ob >> 9) & 1) << 5)); }
__device__ __forceinline__ void stage_rc(int b, int& R, int& C) { const int st = b / 1024, sb = b % 1024, swz = sb ^ (((sb >> 9) & 1) << 5); R = (st >> 1) * 16 + swz / 64; C = (st & 1) * 32 + (swz % 64) / 2; }
__device__ __forceinline__ int perm32(int rho) { const int n = rho >> 4, i = rho & 15; return 8 * (i >> 2) + 4 * n + (i & 3); }

struct Unit { int pm, pn; };
struct Gemm { const bf16_t* A; const bf16_t* Bt; int lda, ldb, K, nM, nN; size_t a_pn_stride; };

struct StaticOrder {
    int nM, nN, nwg, G, c;
    __device__ void init(int nM_, int nN_, int G_, int c_) { nM = nM_; nN = nN_; nwg = nM * nN; G = G_; c = c_; }
    __device__ bool next(int i, Unit& u) const {
        const long L = (long)i * G + c; if (L >= nwg) return false;
        int wgid = (int)L; { const int q = nwg / NXCD, r = nwg % NXCD, xcd = wgid % NXCD, off = wgid / NXCD; wgid = (xcd < r ? xcd * (q + 1) : r * (q + 1) + (xcd - r) * q) + off; }
        const int nig = WGM * nN, gid = wgid / nig, fm = gid * WGM, gsz = (nM - fm) < WGM ? (nM - fm) : WGM;
        u.pm = fm + ((wgid % nig) % gsz); u.pn = (wgid % nig) / gsz; return true;
    }
};


__device__ __forceinline__ float row_rstd(const float* ssq, int row, int fq) {
    float s = 0.f;
#pragma unroll
    for (int j = 0; j < 4; ++j) s += ssq[(size_t)(4 * fq + j) * T + row];
    s += __shfl_xor(s, 16); s += __shfl_xor(s, 32);
    return fast_rsqrt(s * (1.0f / 1024.0f) + EPS);
}

struct EpiSwiglu {
    static constexpr bool PERM = true;
    bf16_t* H; const float* ssq;
    __device__ __forceinline__ void operator()(const f32x4 (&acc)[2][2][4][2], const Unit& u, int wr, int wc, int fr_, int fq_) const {
        int fr = fr_, fq = fq_; asm volatile("" : "+v"(fr), "+v"(fq));
        const int row0 = u.pm * BM + wr * 64 + fr;
#pragma unroll
        for (int ai = 0; ai < 2; ++ai)
#pragma unroll
            for (int m = 0; m < 4; ++m) {
                const int row = row0 + ai * HALF + m * 16;
                const float r = row_rstd(ssq, row, fq);
                const f32x4 g0 = acc[ai][0][m][0] * r, g1 = acc[ai][0][m][1] * r, u0 = acc[ai][1][m][0] * r, u1 = acc[ai][1][m][1] * r;
                u32x4 w;
                w.x = cvt_pk_bf16(silu_mul(g0[0], u0[0]), silu_mul(g0[1], u0[1]));
                w.y = cvt_pk_bf16(silu_mul(g0[2], u0[2]), silu_mul(g0[3], u0[3]));
                w.z = cvt_pk_bf16(silu_mul(g1[0], u1[0]), silu_mul(g1[1], u1[1]));
                w.w = cvt_pk_bf16(silu_mul(g1[2], u1[2]), silu_mul(g1[3], u1[3]));
                *(u32x4*)(H + (size_t)row * FF + u.pn * 128 + wc * 32 + 8 * fq) = w;
            }
    }
};

struct EpiResid {
    static constexpr bool PERM = false;
    const float* res0; const float* res1; float* out; bf16_t* xb; float* ssq; const float* colscale; float cs;
    __device__ __forceinline__ void operator()(const f32x4 (&acc)[2][2][4][2], const Unit& u, int wr, int wc, int fr_, int fq_) const {
        int fr = fr_, fq = fq_; asm volatile("" : "+v"(fr), "+v"(fq));
        const int row0 = u.pm * BM + wr * 64 + fr;
#pragma unroll
        for (int ai = 0; ai < 2; ++ai)
#pragma unroll
            for (int m = 0; m < 4; ++m) {
                const int row = row0 + ai * HALF + m * 16;
                const float* rp = (row < TP) ? res0 + (size_t)row * DM : res1 + (size_t)(row - TP) * DM;
                float sq = 0.f;
#pragma unroll
                for (int bj = 0; bj < 2; ++bj)
#pragma unroll
                    for (int n = 0; n < 2; ++n) {
                        const int col = u.pn * BM + bj * HALF + wc * 32 + n * 16 + 4 * fq;
                        const f32x4 rv = *(const f32x4*)(rp + col);
                        f32x4 sc = (f32x4){cs, cs, cs, cs};
                        if (colscale) sc = *(const f32x4*)(colscale + col);
                        const f32x4 v = rv + acc[ai][bj][m][n] * sc;
                        *(f32x4*)(out + (size_t)row * DM + col) = v;
                        u32x2 w; w.x = cvt_pk_bf16(v[0], v[1]); w.y = cvt_pk_bf16(v[2], v[3]);
                        *(u32x2*)(xb + (size_t)row * DM + col) = w;
                        sq += (v[0] * v[0] + v[1] * v[1]) + (v[2] * v[2] + v[3] * v[3]);
                    }
                sq += __shfl_xor(sq, 16); sq += __shfl_xor(sq, 32);
                if (fq == 0) ssq[(size_t)(u.pn * 4 + wc) * T + row] = sq;
            }
    }
};

struct EpiRawF32 {
    static constexpr bool PERM = false;
    float* O; int ldc; int ncols; const float* ssq;
    __device__ __forceinline__ void operator()(const f32x4 (&acc)[2][2][4][2], const Unit& u, int wr, int wc, int fr_, int fq_) const {
        int fr = fr_, fq = fq_; asm volatile("" : "+v"(fr), "+v"(fq));
        const int row0 = u.pm * BM + wr * 64 + fr;
#pragma unroll
        for (int ai = 0; ai < 2; ++ai)
#pragma unroll
            for (int m = 0; m < 4; ++m) {
                const int row = row0 + ai * HALF + m * 16;
                const float r = row_rstd(ssq, row, fq);
#pragma unroll
                for (int bj = 0; bj < 2; ++bj)
#pragma unroll
                    for (int n = 0; n < 2; ++n) {
                        const int col = u.pn * BM + bj * HALF + wc * 32 + n * 16 + 4 * fq;
                        if (col < ncols) *(f32x4*)(O + (size_t)row * ldc + col) = acc[ai][bj][m][n] * r;
                    }
            }
    }
};

struct EpiRawBf16 {
    static constexpr bool PERM = true;
    bf16_t* O; int ldc;
    __device__ __forceinline__ void operator()(const f32x4 (&acc)[2][2][4][2], const Unit& u, int wr, int wc, int fr_, int fq_) const {
        int fr = fr_, fq = fq_; asm volatile("" : "+v"(fr), "+v"(fq));
        const int row0 = u.pm * BM + wr * 64 + fr;
#pragma unroll
        for (int ai = 0; ai < 2; ++ai)
#pragma unroll
            for (int m = 0; m < 4; ++m) {
                bf16_t* rowp = O + (size_t)(row0 + ai * HALF + m * 16) * ldc + u.pn * BM + wc * 32 + 8 * fq;
#pragma unroll
                for (int bj = 0; bj < 2; ++bj) {
                    const f32x4 v0 = acc[ai][bj][m][0], v1 = acc[ai][bj][m][1];
                    u32x4 w; w.x = cvt_pk_bf16(v0[0], v0[1]); w.y = cvt_pk_bf16(v0[2], v0[3]); w.z = cvt_pk_bf16(v1[0], v1[1]); w.w = cvt_pk_bf16(v1[2], v1[3]);
                    *(u32x4*)(rowp + bj * HALF) = w;
                }
            }
    }
};

template <class Epi>
__device__ __forceinline__ void gemm_phase(LAS unsigned char* lds, const Gemm g, const StaticOrder& S, const Epi& E) {
    int tid = threadIdx.x; asm volatile("" : "+v"(tid));
    const int wid = __builtin_amdgcn_readfirstlane(tid >> 6), lane = tid & 63, wr = wid >> 2, wc = wid & 3, fr = lane & 15, fq = lane >> 4;
    const int K = g.K, nt = K / BK;
    unsigned voffA[2], voffB[2];
#pragma unroll
    for (int i = 0; i < 2; ++i) { int R, C; stage_rc(tid * 16 + i * 8192, R, C); const int Rb = Epi::PERM ? ((R & ~31) + perm32(R & 31)) : R;
        voffA[i] = (unsigned)(R * g.lda + C) * 2u; voffB[i] = (unsigned)(Rb * g.ldb + C) * 2u; }
    const size_t kstep = (size_t)(BK * 2);
    const size_t hA = (size_t)HALF * g.lda * 2, hB = (size_t)HALF * g.ldb * 2;
    const size_t tA = 2 * hA, tB = 2 * hB;
    const unsigned ldsw = (unsigned)wid * 1024u;
    const int aoff = lds_byte(wr * 64 + fr, fq * 8), boff = lds_byte(wc * 32 + fr, fq * 8);
#define PG8_SA(b, h) (((b) * 2 + (h)) * HTB)
#define PG8_SB(b, h) ((4 + (b) * 2 + (h)) * HTB)
#define PG8_STAGE(bufoff, gbase, voff) do { _Pragma("unroll") for (int _i = 0; _i < 2; ++_i) \
        __builtin_amdgcn_global_load_lds((const unsigned*)((const char*)(gbase) + (voff)[_i]), (LAS unsigned*)(lds + (bufoff) + ldsw + _i * 8192), 16, 0, 0); } while (0)
#define PG8_LDA(dst, b, h) do { _Pragma("unroll") for (int m = 0; m < 4; ++m) _Pragma("unroll") for (int k = 0; k < 2; ++k) dst[m][k] = *(const LAS bf16x8*)(lds + PG8_SA(b, h) + aoff + m * 2048 + k * 1024); } while (0)
#define PG8_LDB(dst, b, h) do { _Pragma("unroll") for (int n = 0; n < 2; ++n) _Pragma("unroll") for (int k = 0; k < 2; ++k) dst[n][k] = *(const LAS bf16x8*)(lds + PG8_SB(b, h) + boff + n * 2048 + k * 1024); } while (0)
#define PG8_MMA(ai, bj, At, Bt) do { __builtin_amdgcn_s_setprio(1); _Pragma("unroll") for (int m = 0; m < 4; ++m) _Pragma("unroll") for (int n = 0; n < 2; ++n) _Pragma("unroll") for (int k = 0; k < 2; ++k) \
        acc[ai][bj][m][n] = __builtin_amdgcn_mfma_f32_16x16x32_bf16(Bt[n][k], At[m][k], acc[ai][bj][m][n], 0, 0, 0); __builtin_amdgcn_s_setprio(0); } while (0)
#define PG8_WAIT_V(n) asm volatile("s_waitcnt vmcnt(" #n ")" ::: "memory")
#define PG8_WAIT_L(n) asm volatile("s_waitcnt lgkmcnt(" #n ")" ::: "memory")
#define PG8_BAR __builtin_amdgcn_s_barrier()
#define PG8_SCHED __builtin_amdgcn_sched_barrier(0)
    Unit cur, nxt; int ui = 0;
    if (!S.next(0, cur)) return;
    f32x4 acc[2][2][4][2];
#pragma unroll
    for (int a = 0; a < 2; ++a)
#pragma unroll
        for (int b = 0; b < 2; ++b)
#pragma unroll
            for (int m = 0; m < 4; ++m)
#pragma unroll
                for (int n = 0; n < 2; ++n) acc[a][b][m][n] = (f32x4){0.f, 0.f, 0.f, 0.f};
    bf16x8 At[4][2], B0[2][2], B1[2][2];
    const char* cA = (const char*)g.A + (size_t)cur.pm * tA + (size_t)cur.pn * g.a_pn_stride; const char* cB = (const char*)g.Bt + (size_t)cur.pn * tB;
    PG8_STAGE(PG8_SB(0, 0), cB, voffB); PG8_STAGE(PG8_SB(0, 1), cB + hB, voffB); PG8_STAGE(PG8_SA(0, 0), cA, voffA); PG8_STAGE(PG8_SA(0, 1), cA + hA, voffA);
    if (wr == 1) PG8_BAR;
    PG8_WAIT_V(2); PG8_BAR;
    PG8_STAGE(PG8_SB(1, 0), cB + kstep, voffB); PG8_STAGE(PG8_SA(1, 0), cA + kstep, voffA); PG8_STAGE(PG8_SB(1, 1), cB + hB + kstep, voffB);
    PG8_WAIT_V(6); PG8_BAR;
    for (;;) {
        const bool has_next = S.next(ui + 1, nxt);
        const char* nA = has_next ? (const char*)g.A + (size_t)nxt.pm * tA + (size_t)nxt.pn * g.a_pn_stride : cA; const char* nB = has_next ? (const char*)g.Bt + (size_t)nxt.pn * tB : cB;
        for (int t = 0; t < nt; t += 2) {
            const bool last = (t == nt - 2);
            const char* a1 = cA + (size_t)(t + 1) * kstep;
            const char* a2 = last ? nA : cA + (size_t)(t + 2) * kstep; const char* b2 = last ? nB : cB + (size_t)(t + 2) * kstep;
            const char* a3 = a2 + kstep; const char* b3 = b2 + kstep;
            PG8_LDB(B0, 0, 0); PG8_LDB(B1, 0, 1); PG8_SCHED; PG8_LDA(At, 0, 0); PG8_STAGE(PG8_SA(1, 1), a1 + hA, voffA);
            PG8_WAIT_V(8); PG8_WAIT_L(0); PG8_BAR; PG8_MMA(0, 0, At, B0); PG8_MMA(0, 1, At, B1); PG8_BAR; PG8_SCHED;
            PG8_LDA(At, 0, 1); PG8_STAGE(PG8_SB(0, 0), b2, voffB); PG8_STAGE(PG8_SB(0, 1), b2 + hB, voffB); PG8_STAGE(PG8_SA(0, 0), a2, voffA);
            PG8_WAIT_V(8); PG8_WAIT_L(0); PG8_BAR; PG8_MMA(1, 0, At, B0); PG8_MMA(1, 1, At, B1); PG8_BAR; PG8_SCHED;
            PG8_LDB(B0, 1, 0); PG8_LDB(B1, 1, 1); PG8_SCHED; PG8_LDA(At, 1, 0); PG8_STAGE(PG8_SA(0, 1), a2 + hA, voffA);
            PG8_WAIT_V(8); PG8_WAIT_L(0); PG8_BAR; PG8_MMA(0, 0, At, B0); PG8_MMA(0, 1, At, B1); PG8_BAR; PG8_SCHED;
            PG8_LDA(At, 1, 1); PG8_STAGE(PG8_SB(1, 0), b3, voffB); PG8_STAGE(PG8_SB(1, 1), b3 + hB, voffB); PG8_STAGE(PG8_SA(1, 0), a3, voffA);
            PG8_WAIT_V(8); PG8_WAIT_L(0); PG8_BAR; PG8_MMA(1, 0, At, B0); PG8_MMA(1, 1, At, B1); PG8_BAR; PG8_SCHED;
        }
        if (wr == 0) PG8_BAR;
        E(acc, cur, wr, wc, fr, fq);
        if (!has_next) break;
#pragma unroll
        for (int a = 0; a < 2; ++a)
#pragma unroll
            for (int b = 0; b < 2; ++b)
#pragma unroll
                for (int m = 0; m < 4; ++m)
#pragma unroll
                    for (int n = 0; n < 2; ++n) acc[a][b][m][n] = (f32x4){0.f, 0.f, 0.f, 0.f};
        cur = nxt; cA = nA; cB = nB; ++ui;
        if (wr == 1) PG8_BAR;
    }
    PG8_WAIT_V(0);
    PG8_BAR;
#undef PG8_SA
#undef PG8_SB
#undef PG8_STAGE
#undef PG8_LDA
#undef PG8_LDB
#undef PG8_MMA
#undef PG8_WAIT_V
#undef PG8_WAIT_L
#undef PG8_BAR
#undef PG8_SCHED
}
}

__device__ __forceinline__ float wave_sum(float v) {
#pragma unroll
    for (int o = 1; o < 64; o <<= 1) v += __shfl_xor(v, o);
    return v;
}
__device__ __forceinline__ void conv_weight(const float* W, int K, int N, bf16_t* WT, const float* gain, int mode, int row_off, LAS float* scr, int gw, int NGW, int lane) {
    const int nblk = N / 32, nitems = (K / 64) * nblk;
    for (int item = gw; item < nitems; item += NGW) {
        const int kb = item / nblk, nb = item % nblk, k0 = 64 * kb, n0 = 32 * nb;
#pragma unroll 8
        for (int i = 0; i < 32; ++i) { const int kk = 2 * i + (lane >> 5); float v = W[(size_t)(k0 + kk) * N + n0 + (lane & 31)]; if (gain) v *= gain[k0 + kk]; scr[kk * 33 + (lane & 31)] = v; }
        asm volatile("s_waitcnt lgkmcnt(0)" ::: "memory");
        const int c = lane & 7;
#pragma unroll
        for (int j = 0; j < 4; ++j) {
            const int n = (lane >> 3) + 8 * j; const LAS float* s = scr + (8 * c) * 33 + n;
            u32x4 o; o.x = cvt_pk_bf16(s[0 * 33], s[1 * 33]); o.y = cvt_pk_bf16(s[2 * 33], s[3 * 33]); o.z = cvt_pk_bf16(s[4 * 33], s[5 * 33]); o.w = cvt_pk_bf16(s[6 * 33], s[7 * 33]);
            const int na = n0 + n; int row;
            if (mode == 1) { const int up = na >= FF ? 1 : 0; const int jn = na - up * FF; row = 256 * (jn >> 7) + 128 * up + (jn & 127); }
            else row = row_off + na;
            *(u32x4*)(WT + (size_t)row * K + k0 + 8 * c) = o;
        }
        asm volatile("s_waitcnt lgkmcnt(0)" ::: "memory");
    }
}

__device__ __forceinline__ void phase0(const Params& p, LAS unsigned char* lds, int G, int c) {
    int tid = threadIdx.x; asm volatile("" : "+v"(tid));
    const int lane = tid & 63, wave = tid >> 6;
    LAS float* scr = (LAS float*)(lds + wave * 8704);
    const int gw = c * 8 + wave, NGW = G * 8;
    unsigned char* ws = p.ws;
    for (int l = 0; l < 4; ++l) {
        conv_weight(p.in[6] + (size_t)l * 1024 * 5632, 1024, 5632, (bf16_t*)(ws + WS_WIN + (size_t)(2 * l) * SZ_WIN), p.in[5] + l * 1024, 1, 0, scr, gw, NGW, lane);
        conv_weight(p.in[10] + (size_t)l * 1024 * 5632, 1024, 5632, (bf16_t*)(ws + WS_WIN + (size_t)(2 * l + 1) * SZ_WIN), p.in[9] + l * 1024, 1, 0, scr, gw, NGW, lane);
        conv_weight(p.in[7] + (size_t)l * 2816 * 1024, 2816, 1024, (bf16_t*)(ws + WS_WOUT + (size_t)(2 * l) * SZ_WOUT), nullptr, 0, 0, scr, gw, NGW, lane);
        conv_weight(p.in[11] + (size_t)l * 2816 * 1024, 2816, 1024, (bf16_t*)(ws + WS_WOUT + (size_t)(2 * l + 1) * SZ_WOUT), nullptr, 0, 0, scr, gw, NGW, lane);
    }
    for (int lg = 0; lg < 8; ++lg)
        conv_weight(p.in[12] + (size_t)lg * 65536, 256, 256, (bf16_t*)(ws + WS_WPOOL) + (size_t)(lg >> 2) * 1024 * 256, nullptr, 0, (lg & 3) * 256, scr, gw, NGW, lane);
    conv_weight(p.in[15], 1024, 256, (bf16_t*)(ws + WS_WDKV), p.in[14], 0, 0, scr, gw, NGW, lane);
    conv_weight(p.in[17], 1024, 64, (bf16_t*)(ws + WS_WDKV), p.in[14], 0, 256, scr, gw, NGW, lane);
    conv_weight(p.in[19], 256, 1024, (bf16_t*)(ws + WS_WUK), nullptr, 0, 0, scr, gw, NGW, lane);
    conv_weight(p.in[21], 256, 1024, (bf16_t*)(ws + WS_WUV), nullptr, 0, 0, scr, gw, NGW, lane);
    for (int i = 0; i < 2; ++i) {
        conv_weight(p.in[22] + (size_t)i * 1024 * 384, 1024, 384, (bf16_t*)(ws + WS_WDQ) + (size_t)i * 512 * 1024, p.in[8] + (2 + i) * 1024, 0, 0, scr, gw, NGW, lane);
        conv_weight(p.in[24] + (size_t)i * 384 * 1536, 384, 1536, (bf16_t*)(ws + WS_WUQ) + (size_t)i * 1536 * 384, p.in[23] + i * 384, 0, 0, scr, gw, NGW, lane);
        conv_weight(p.in[27] + (size_t)i * 1024 * 1024, 1024, 1024, (bf16_t*)(ws + WS_WO) + (size_t)i * 1024 * 1024, nullptr, 0, 0, scr, gw, NGW, lane);
    }
    {
        const int gt = c * NTHREADS + tid, NGT = G * NTHREADS;
        const u32x4 z = (u32x4){0u, 0u, 0u, 0u};
        u32x4* d0 = (u32x4*)((bf16_t*)(ws + WS_WDKV) + (size_t)320 * 1024);
        for (int i = gt; i < 192 * 1024 / 8; i += NGT) d0[i] = z;
        for (int q = 0; q < 2; ++q) { u32x4* d1 = (u32x4*)((bf16_t*)(ws + WS_WDQ) + (size_t)q * 512 * 1024 + (size_t)384 * 1024);
            for (int i = gt; i < 128 * 1024 / 8; i += NGT) d1[i] = z; }
        float* ct = (float*)(ws + WS_ROPE); float* st = ct + 2048 * 32;
        for (int i = gt; i < 2048 * 32; i += NGT) {
            const int pos = i >> 5, j = i & 31;
            const float inv = exp2f(-(float)j * 0.41524101186092029f);
            const float rev = (float)pos * inv * 0.15915494309189535f;
            const float fr = rev - floorf(rev);
            ct[i] = __builtin_amdgcn_cosf(fr); st[i] = __builtin_amdgcn_sinf(fr);
        }
    }
    {
        bf16_t* xb = (bf16_t*)(ws + WS_XB); float* ssq = (float*)(ws + WS_SSQ);
        for (int row = gw; row < T; row += NGW) {
            const float* xr = (row < TP) ? p.in[0] + (size_t)row * DM : p.in[1] + (size_t)(row - TP) * DM;
            float s = 0.f;
#pragma unroll
            for (int j = 0; j < 4; ++j) {
                const f32x4 v = *(const f32x4*)(xr + 4 * lane + 256 * j);
                s += (v[0] * v[0] + v[1] * v[1]) + (v[2] * v[2] + v[3] * v[3]);
                u32x2 w; w.x = cvt_pk_bf16(v[0], v[1]); w.y = cvt_pk_bf16(v[2], v[3]);
                *(u32x2*)(xb + (size_t)row * DM + 4 * lane + 256 * j) = w;
            }
            s = wave_sum(s);
            if (lane < 16) ssq[(size_t)lane * T + row] = (lane == 0) ? s : 0.f;
        }
    }
}

template <int W>
__device__ __forceinline__ void pool_item(const float* x, const float* prev, bool samp, int rowbase, int s0, int S, int start, int col, int grp, f32x2 g2,
                                          const LAS float* lrs, bf16_t* Dp, float* opool) {
    f32x2 h[31 + W];
#pragma unroll
    for (int j = -(W - 1); j < 32; ++j) {
        const int s = s0 + j;
        const float* src = (s >= 0) ? x + (size_t)(rowbase + s) * DM + col : (samp ? prev + (size_t)(15 + s) * DM + col : x + (size_t)rowbase * DM + col);
        h[j + W - 1] = *(const f32x2*)src;
    }
#pragma unroll
    for (int j = -(W - 1); j < 32; ++j) {
        const int s = s0 + j;
        f32x2 sc;
        if (s >= 0) { const float r = lrs[j + 15]; sc = (f32x2){r * g2.x, r * g2.y}; }
        else sc = samp ? (f32x2){1.f, 1.f} : (f32x2){0.f, 0.f};
        h[j + W - 1] = h[j + W - 1] * sc;
    }
    f32x2 sum = (f32x2){0.f, 0.f};
#pragma unroll
    for (int j = 0; j < W - 1; ++j) sum += h[j];
#pragma unroll
    for (int j = 0; j < 32; ++j) {
        const int s = s0 + j;
        const f32x2 hs = h[j + W - 1]; sum += hs;
        const int pos = start + s; const int cnt = (pos + 1 < W) ? pos + 1 : W;
        const float ic = 1.0f / (float)cnt;
        const f32x2 d = (f32x2){sum.x * ic - hs.x, sum.y * ic - hs.y};
        *(unsigned*)(Dp + ((size_t)grp * T + rowbase + s) * 256 + (col & 255)) = cvt_pk_bf16(d.x, d.y);
        if (s >= S - 15) *(f32x2*)(opool + (size_t)(s - (S - 15)) * DM + col) = hs;
        sum -= h[j];
    }
}
__device__ __forceinline__ void pool_prep(const Params& p, int layer, const float* ssq, LAS unsigned char* lds, int G, int c) {
    int tid = threadIdx.x; asm volatile("" : "+v"(tid));
    LAS float* lrs = (LAS float*)lds;
    const float* x = p.out;
    const float* gain = p.in[8] + layer * DM;
    bf16_t* Dp = (bf16_t*)(p.ws + WS_D);
    const int col = 2 * tid, grp = __builtin_amdgcn_readfirstlane(tid >> 7);
    const f32x2 g2 = *(const f32x2*)(gain + col);
    for (int item = c; item < 2048 + 8; item += G) {
        const bool samp = item >= 2048;
        int b, s0, S, rowbase, start;
        if (!samp) { b = item >> 6; s0 = (item & 63) * 32; rowbase = b * SEQ; S = SEQ; start = 0; }
        else { b = item - 2048; s0 = 0; rowbase = TP + b * DSEQ; S = DSEQ; start = PAST; }
        if (tid < 47) {
            const int s = s0 - 15 + tid; float r = 0.f;
            if (s >= 0) { const int row = rowbase + s; float sum = 0.f;
#pragma unroll
                for (int j = 0; j < 16; ++j) sum += ssq[(size_t)j * T + row];
                r = fast_rsqrt(sum * (1.0f / 1024.0f) + EPS); }
            lrs[tid] = r;
        }
        __syncthreads();
        const float* prev = p.in[2] + ((size_t)(layer * DBATCH + b) * 15) * DM;
        float* opool = samp ? p.out + OUT_POOL_S + ((size_t)(layer * DBATCH + b) * 15) * DM : p.out + OUT_POOL_P + ((size_t)(layer * NBATCH + b) * 15) * DM;
        if (grp == 0) pool_item<2>(x, prev, samp, rowbase, s0, S, start, col, grp, g2, lrs, Dp, opool);
        else if (grp == 1) pool_item<4>(x, prev, samp, rowbase, s0, S, start, col, grp, g2, lrs, Dp, opool);
        else if (grp == 2) pool_item<8>(x, prev, samp, rowbase, s0, S, start, col, grp, g2, lrs, Dp, opool);
        else pool_item<16>(x, prev, samp, rowbase, s0, S, start, col, grp, g2, lrs, Dp, opool);
        __syncthreads();
    }
}

__device__ __forceinline__ void latent_norm(const Params& p, int G, int c) {
    int tid = threadIdx.x; asm volatile("" : "+v"(tid));
    const int lane = tid & 63, wave = tid >> 6;
    const int gw = c * 8 + wave, NGW = G * 8;
    const float* raw = (const float*)(p.ws + WS_LATRAW);
    bf16_t* call = (bf16_t*)(p.ws + WS_CALL); bf16_t* krb = (bf16_t*)(p.ws + WS_KR);
    const float* ct = (const float*)(p.ws + WS_ROPE); const float* st = ct + 2048 * 32;
    const f32x4 cg4 = *(const f32x4*)(p.in[16] + 4 * lane);
    const float kg = p.in[18][lane];
    for (int row = gw; row < T; row += NGW) {
        const float* rr = raw + (size_t)row * LATW;
        const f32x4 v = *(const f32x4*)(rr + 4 * lane);
        const float kv = rr[256 + lane];
        const float sc = wave_sum((v[0] * v[0] + v[1] * v[1]) + (v[2] * v[2] + v[3] * v[3]));
        const float sk = wave_sum(kv * kv);
        const float rc = fast_rsqrt(sc * (1.0f / 256.0f) + EPS), rk = fast_rsqrt(sk * (1.0f / 64.0f) + EPS);
        const f32x4 cv = (f32x4){v[0] * rc * cg4[0], v[1] * rc * cg4[1], v[2] * rc * cg4[2], v[3] * rc * cg4[3]};
        const float kn = kv * rk * kg;
        int pos, krow; float* oc; float* ok;
        if (row < TP) { pos = row & (SEQ - 1); krow = row; oc = p.out + OUT_CKV_P + (size_t)row * 256; ok = p.out + OUT_KR_P + (size_t)row * 64; }
        else { const int r2 = row - TP, b = r2 >> 5, s = r2 & 31; pos = PAST + s; krow = TP + b * SKEY + PAST + s; oc = p.out + OUT_CKV_S + (size_t)r2 * 256; ok = p.out + OUT_KR_S + (size_t)r2 * 64; }
        const float other = __shfl_xor(kn, 32);
        const float cs = ct[pos * 32 + (lane & 31)], sn = st[pos * 32 + (lane & 31)];
        const float ko = (lane < 32) ? (kn * cs - other * sn) : (kn * cs + other * sn);
        *(f32x4*)(oc + 4 * lane) = cv;
        ok[lane] = ko;
        u32x2 w; w.x = cvt_pk_bf16(cv[0], cv[1]); w.y = cvt_pk_bf16(cv[2], cv[3]);
        *(u32x2*)(call + (size_t)krow * 256 + 4 * lane) = w;
        const float kon = __shfl_down(ko, 1);
        if ((lane & 1) == 0) *(unsigned*)(krb + (size_t)krow * 64 + lane) = cvt_pk_bf16(ko, kon);
    }
    for (int r = gw; r < DBATCH * SKEY; r += NGW) {
        const int b = r / SKEY, t = r % SKEY; const int krow = TP + r;
        if (t >= PAST && t < PAST + DSEQ) continue;
        u32x2 w = (u32x2){0u, 0u}; unsigned kw = 0u;
        if (t < PAST) {
            const f32x4 v = *(const f32x4*)(p.in[3] + ((size_t)b * PAST + t) * 256 + 4 * lane);
            w.x = cvt_pk_bf16(v[0], v[1]); w.y = cvt_pk_bf16(v[2], v[3]);
            if (lane < 32) { const f32x2 k2 = *(const f32x2*)(p.in[4] + ((size_t)b * PAST + t) * 64 + 2 * lane); kw = cvt_pk_bf16(k2.x, k2.y); }
        }
        *(u32x2*)(call + (size_t)krow * 256 + 4 * lane) = w;
        if (lane < 32) *(unsigned*)(krb + (size_t)krow * 64 + 2 * lane) = kw;
    }
}

__device__ __forceinline__ void unpack16(const u32x4 a, const u32x4 b, float (&v)[16]) {
    v[0] = bflo(a.x); v[1] = bfhi(a.x); v[2] = bflo(a.y); v[3] = bfhi(a.y); v[4] = bflo(a.z); v[5] = bfhi(a.z); v[6] = bflo(a.w); v[7] = bfhi(a.w);
    v[8] = bflo(b.x); v[9] = bfhi(b.x); v[10] = bflo(b.y); v[11] = bfhi(b.y); v[12] = bflo(b.z); v[13] = bfhi(b.z); v[14] = bflo(b.w); v[15] = bfhi(b.w);
}
__device__ __forceinline__ void k_assemble(const Params& p, int G, int c) {
    int tid = threadIdx.x; asm volatile("" : "+v"(tid));
    const int lane = tid & 63, wave = tid >> 6;
    const int gw = c * 8 + wave, NGW = G * 8;
    bf16_t* kn = (bf16_t*)(p.ws + WS_KN);
    const float* g = p.in[20] + (lane & 7) * 16;
    float gg[16];
#pragma unroll
    for (int i = 0; i < 16; ++i) gg[i] = g[i];
    for (int row0 = gw * 4; row0 < TALL; row0 += NGW * 4) {
        u32x4 a[4], b[4];
#pragma unroll
        for (int q = 0; q < 4; ++q) { const u32x4* ptr = (const u32x4*)(kn + (size_t)(row0 + q) * 1024 + lane * 16); a[q] = ptr[0]; b[q] = ptr[1]; }
#pragma unroll
        for (int q = 0; q < 4; ++q) {
            float v[16]; unpack16(a[q], b[q], v);
            float s = 0.f;
#pragma unroll
            for (int i = 0; i < 16; ++i) s += v[i] * v[i];
            s += __shfl_xor(s, 1); s += __shfl_xor(s, 2); s += __shfl_xor(s, 4);
            const float r = fast_rsqrt(s * (1.0f / 128.0f) + EPS);
            u32x4 oa, ob;
            oa.x = cvt_pk_bf16(v[0] * r * gg[0], v[1] * r * gg[1]); oa.y = cvt_pk_bf16(v[2] * r * gg[2], v[3] * r * gg[3]);
            oa.z = cvt_pk_bf16(v[4] * r * gg[4], v[5] * r * gg[5]); oa.w = cvt_pk_bf16(v[6] * r * gg[6], v[7] * r * gg[7]);
            ob.x = cvt_pk_bf16(v[8] * r * gg[8], v[9] * r * gg[9]); ob.y = cvt_pk_bf16(v[10] * r * gg[10], v[11] * r * gg[11]);
            ob.z = cvt_pk_bf16(v[12] * r * gg[12], v[13] * r * gg[13]); ob.w = cvt_pk_bf16(v[14] * r * gg[14], v[15] * r * gg[15]);
            u32x4* ptr = (u32x4*)(kn + (size_t)(row0 + q) * 1024 + lane * 16);
            ptr[0] = oa; ptr[1] = ob;
        }
    }
}

__device__ __forceinline__ void qlat_norm(const Params& p, int G, int c) {
    int tid = threadIdx.x; asm volatile("" : "+v"(tid));
    const int lane = tid & 63, wave = tid >> 6;
    const int gw = c * 8 + wave, NGW = G * 8;
    const float* raw = (const float*)(p.ws + WS_DQRAW); bf16_t* ql = (bf16_t*)(p.ws + WS_QLAT);
    for (int row0 = gw * 4; row0 < T; row0 += NGW * 4) {
        f32x2 v[4][3];
#pragma unroll
        for (int q = 0; q < 4; ++q)
#pragma unroll
            for (int j = 0; j < 3; ++j) v[q][j] = *(const f32x2*)(raw + (size_t)(row0 + q) * QL + 2 * lane + 128 * j);
#pragma unroll
        for (int q = 0; q < 4; ++q) {
            float s = 0.f;
#pragma unroll
            for (int j = 0; j < 3; ++j) s += v[q][j].x * v[q][j].x + v[q][j].y * v[q][j].y;
            s = wave_sum(s);
            const float r = fast_rsqrt(s * (1.0f / 384.0f) + EPS);
#pragma unroll
            for (int j = 0; j < 3; ++j) *(unsigned*)(ql + (size_t)(row0 + q) * QL + 2 * lane + 128 * j) = cvt_pk_bf16(v[q][j].x * r, v[q][j].y * r);
        }
    }
}

__device__ __forceinline__ void q_assemble(const Params& p, int i, int G, int c) {
    int tid = threadIdx.x; asm volatile("" : "+v"(tid));
    const int lane = tid & 63, wave = tid >> 6;
    const int gw = c * 8 + wave, NGW = G * 8;
    bf16_t* Q = (bf16_t*)(p.ws + WS_Q);
    const float* ct = (const float*)(p.ws + WS_ROPE); const float* st = ct + 2048 * 32;
    const int head = lane >> 3, sub = lane & 7;
    const float SC = 0.07216878364870323f * 1.4426950408889634f;
    float gn[16], gr[8];
#pragma unroll
    for (int j = 0; j < 16; ++j) gn[j] = p.in[25][i * 128 + sub * 16 + j] * SC;
#pragma unroll
    for (int j = 0; j < 8; ++j) gr[j] = p.in[26][i * 64 + sub * 8 + j];
    const int jb = (sub & 3) * 8;
    for (int row0 = gw * 2; row0 < T; row0 += NGW * 2) {
        u32x4 a[2], b[2], rw[2]; f32x4 c0[2], c1[2], n0[2], n1[2];
#pragma unroll
        for (int q = 0; q < 2; ++q) {
            const int row = row0 + q;
            const int pos = (row < TP) ? (row & (SEQ - 1)) : (PAST + ((row - TP) & 31));
            const bf16_t* qh = Q + (size_t)row * HQ + head * 192;
            const u32x4* pn = (const u32x4*)(qh + sub * 16); const u32x4* pr = (const u32x4*)(qh + 128 + sub * 8);
            a[q] = pn[0]; b[q] = pn[1]; rw[q] = pr[0];
            c0[q] = *(const f32x4*)(ct + pos * 32 + jb); c1[q] = *(const f32x4*)(ct + pos * 32 + jb + 4);
            n0[q] = *(const f32x4*)(st + pos * 32 + jb); n1[q] = *(const f32x4*)(st + pos * 32 + jb + 4);
        }
#pragma unroll
        for (int q = 0; q < 2; ++q) {
            const int row = row0 + q;
            bf16_t* qh = Q + (size_t)row * HQ + head * 192;
            u32x4* pn = (u32x4*)(qh + sub * 16); u32x4* pr = (u32x4*)(qh + 128 + sub * 8);
            float v[16], rv[8];
            unpack16(a[q], b[q], v);
            rv[0] = bflo(rw[q].x); rv[1] = bfhi(rw[q].x); rv[2] = bflo(rw[q].y); rv[3] = bfhi(rw[q].y); rv[4] = bflo(rw[q].z); rv[5] = bfhi(rw[q].z); rv[6] = bflo(rw[q].w); rv[7] = bfhi(rw[q].w);
            float s = 0.f, s2 = 0.f;
#pragma unroll
            for (int j = 0; j < 16; ++j) s += v[j] * v[j];
#pragma unroll
            for (int j = 0; j < 8; ++j) s2 += rv[j] * rv[j];
            s += __shfl_xor(s, 1); s += __shfl_xor(s, 2); s += __shfl_xor(s, 4);
            s2 += __shfl_xor(s2, 1); s2 += __shfl_xor(s2, 2); s2 += __shfl_xor(s2, 4);
            const float rn = fast_rsqrt(s * (1.0f / 128.0f) + EPS), rr = fast_rsqrt(s2 * (1.0f / 64.0f) + EPS);
            u32x4 oa, ob;
            oa.x = cvt_pk_bf16(v[0] * rn * gn[0], v[1] * rn * gn[1]); oa.y = cvt_pk_bf16(v[2] * rn * gn[2], v[3] * rn * gn[3]);
            oa.z = cvt_pk_bf16(v[4] * rn * gn[4], v[5] * rn * gn[5]); oa.w = cvt_pk_bf16(v[6] * rn * gn[6], v[7] * rn * gn[7]);
            ob.x = cvt_pk_bf16(v[8] * rn * gn[8], v[9] * rn * gn[9]); ob.y = cvt_pk_bf16(v[10] * rn * gn[10], v[11] * rn * gn[11]);
            ob.z = cvt_pk_bf16(v[12] * rn * gn[12], v[13] * rn * gn[13]); ob.w = cvt_pk_bf16(v[14] * rn * gn[14], v[15] * rn * gn[15]);
            pn[0] = oa; pn[1] = ob;
            float o[8];
#pragma unroll
            for (int j = 0; j < 8; ++j) {
                const float me = rv[j] * rr * gr[j];
                const float other = __shfl_xor(me, 4);
                const float cs = (j < 4) ? c0[q][j & 3] : c1[q][j & 3], sn = (j < 4) ? n0[q][j & 3] : n1[q][j & 3];
                o[j] = ((sub < 4) ? (me * cs - other * sn) : (me * cs + other * sn)) * SC;
            }
            u32x4 orr; orr.x = cvt_pk_bf16(o[0], o[1]); orr.y = cvt_pk_bf16(o[2], o[3]); orr.z = cvt_pk_bf16(o[4], o[5]); orr.w = cvt_pk_bf16(o[6], o[7]);
            pr[0] = orr;
        }
    }
}

#define MFMA32(a, b, c) __builtin_amdgcn_mfma_f32_32x32x16_bf16((a), (b), (c), 0, 0, 0)
constexpr int KSTR = 400, VSTR = 144, KBUF = 64 * KSTR, VBUF = 128 * VSTR, ABUF = KBUF + VBUF;
__device__ __forceinline__ void attn_phase(const Params& p, LAS unsigned char* lds, int G, int c) {
    int tid = threadIdx.x; asm volatile("" : "+v"(tid));
    const int wid = __builtin_amdgcn_readfirstlane(tid >> 6), lane = tid & 63, l32 = lane & 31, hi = lane >> 5;
    const bf16_t* Q = (const bf16_t*)(p.ws + WS_Q); const bf16_t* KN = (const bf16_t*)(p.ws + WS_KN); const bf16_t* KR = (const bf16_t*)(p.ws + WS_KR);
    const bf16_t* VT = (const bf16_t*)(p.ws + WS_VT); bf16_t* O = (bf16_t*)(p.ws + WS_O);
    for (int idx = c; idx < 2048 + 64; idx += G) {
        int h, qrow0, krow0, ntiles, wave_last; bool partial;
        if (idx < 2048) { const int bh = idx & 255, r = idx >> 8, qblk = (r & 1) ? (r >> 1) : 7 - (r >> 1), b = bh >> 3; h = bh & 7;
            qrow0 = b * SEQ + qblk * 256; krow0 = b * SEQ; ntiles = 4 * qblk + 4; wave_last = 4 * qblk + (wid >> 1); partial = false; }
        else { const int s = idx - 2048, b = s >> 3; h = s & 7; qrow0 = TP + b * DSEQ; krow0 = TP + b * SKEY; ntiles = 17; wave_last = (wid == 0) ? 16 : -1; partial = true; }
        const bool active = wave_last >= 0;
        bf16x8 qf[12];
        if (active) {
            const bf16_t* qp = Q + (size_t)(qrow0 + wid * 32 + l32) * HQ + h * 192 + hi * 8;
#pragma unroll
            for (int kk = 0; kk < 12; ++kk) qf[kk] = *(const bf16x8*)(qp + kk * 16);
        } else {
#pragma unroll
            for (int kk = 0; kk < 12; ++kk) qf[kk] = (bf16x8){0, 0, 0, 0, 0, 0, 0, 0};
        }
        f32x16 o[4];
#pragma unroll
        for (int d = 0; d < 4; ++d)
#pragma unroll
            for (int r = 0; r < 16; ++r) o[d][r] = 0.f;
        float mrun = -INFINITY, lsum = 0.f;
        const int kp0 = tid, kp1 = tid + 512;
        const int rk = tid >> 3, rc = tid & 7;
        const int vp0 = tid, vp1 = tid + 512;
        const bf16_t* gk0 = KN + (size_t)(krow0 + (kp0 >> 4)) * 1024 + h * 128 + (kp0 & 15) * 8;
        const bf16_t* gk1 = KN + (size_t)(krow0 + (kp1 >> 4)) * 1024 + h * 128 + (kp1 & 15) * 8;
        const bf16_t* gr = KR + (size_t)(krow0 + rk) * 64 + rc * 8;
        const bf16_t* gv0 = VT + (size_t)(h * 128 + (vp0 >> 3)) * TALL + krow0 + (vp0 & 7) * 8;
        const bf16_t* gv1 = VT + (size_t)(h * 128 + (vp1 >> 3)) * TALL + krow0 + (vp1 & 7) * 8;
        const int lk0 = (kp0 >> 4) * KSTR + (kp0 & 15) * 16, lk1 = (kp1 >> 4) * KSTR + (kp1 & 15) * 16, lr = rk * KSTR + 256 + rc * 16;
        const int lv0 = KBUF + (vp0 >> 3) * VSTR + ((vp0 & 7) >> 1) * 32 + 8 * (vp0 & 1);
        const int lv1 = KBUF + (vp1 >> 3) * VSTR + ((vp1 & 7) >> 1) * 32 + 8 * (vp1 & 1);
        u32x4 sk0, sk1, sr, sv0, sv1;
#define ATT_LOAD(t) do { sk0 = *(const u32x4*)(gk0 + (size_t)(t) * 64 * 1024); sk1 = *(const u32x4*)(gk1 + (size_t)(t) * 64 * 1024); sr = *(const u32x4*)(gr + (size_t)(t) * 64 * 64); \
                         sv0 = *(const u32x4*)(gv0 + (t) * 64); sv1 = *(const u32x4*)(gv1 + (t) * 64); } while (0)
#define ATT_WRITE(bufp) do { LAS unsigned char* _b = (bufp); *(LAS u32x4*)(_b + lk0) = sk0; *(LAS u32x4*)(_b + lk1) = sk1; *(LAS u32x4*)(_b + lr) = sr; \
                         *(LAS u32x2*)(_b + lv0) = (u32x2){sv0.x, sv0.y}; *(LAS u32x2*)(_b + lv0 + 16) = (u32x2){sv0.z, sv0.w}; \
                         *(LAS u32x2*)(_b + lv1) = (u32x2){sv1.x, sv1.y}; *(LAS u32x2*)(_b + lv1 + 16) = (u32x2){sv1.z, sv1.w}; } while (0)
        ATT_LOAD(0);
        ATT_WRITE(lds);
        __syncthreads();
        for (int t = 0; t < ntiles; ++t) {
            LAS unsigned char* buf = lds + (t & 1) * ABUF;
            if (t + 1 < ntiles) ATT_LOAD(t + 1);
            if (t <= wave_last) {
                f32x16 s0, s1;
#pragma unroll
                for (int r = 0; r < 16; ++r) { s0[r] = 0.f; s1[r] = 0.f; }
                const LAS unsigned char* kb = buf + l32 * KSTR + hi * 16;
#pragma unroll
                for (int kk = 0; kk < 12; ++kk) {
                    const bf16x8 a0 = *(const LAS bf16x8*)(kb + kk * 32);
                    const bf16x8 a1 = *(const LAS bf16x8*)(kb + 32 * KSTR + kk * 32);
                    s0 = MFMA32(a0, qf[kk], s0);
                    s1 = MFMA32(a1, qf[kk], s1);
                }
                if (partial && t == ntiles - 1) {
#pragma unroll
                    for (int r = 0; r < 16; ++r) s1[r] = -INFINITY;
                }
                float mx = s0[0];
#pragma unroll
                for (int r = 1; r < 16; ++r) mx = fmaxf(mx, s0[r]);
#pragma unroll
                for (int r = 0; r < 16; ++r) mx = fmaxf(mx, s1[r]);
                mx = fmaxf(mx, __shfl_xor(mx, 32));
                const float mnew = fmaxf(mrun, mx);
                const float alpha = __builtin_amdgcn_exp2f(mrun - mnew);
                mrun = mnew;
                float rs = 0.f;
#pragma unroll
                for (int r = 0; r < 16; ++r) { s0[r] = __builtin_amdgcn_exp2f(s0[r] - mnew); s1[r] = __builtin_amdgcn_exp2f(s1[r] - mnew); rs += s0[r] + s1[r]; }
                lsum = lsum * alpha + rs;
#pragma unroll
                for (int d = 0; d < 4; ++d)
#pragma unroll
                    for (int r = 0; r < 16; ++r) o[d][r] *= alpha;
                bf16x8 pf[4];
                {
                    u32x4 w;
                    w.x = cvt_pk_bf16(s0[0], s0[1]); w.y = cvt_pk_bf16(s0[2], s0[3]); w.z = cvt_pk_bf16(s0[4], s0[5]); w.w = cvt_pk_bf16(s0[6], s0[7]); pf[0] = __builtin_bit_cast(bf16x8, w);
                    w.x = cvt_pk_bf16(s0[8], s0[9]); w.y = cvt_pk_bf16(s0[10], s0[11]); w.z = cvt_pk_bf16(s0[12], s0[13]); w.w = cvt_pk_bf16(s0[14], s0[15]); pf[1] = __builtin_bit_cast(bf16x8, w);
                    w.x = cvt_pk_bf16(s1[0], s1[1]); w.y = cvt_pk_bf16(s1[2], s1[3]); w.z = cvt_pk_bf16(s1[4], s1[5]); w.w = cvt_pk_bf16(s1[6], s1[7]); pf[2] = __builtin_bit_cast(bf16x8, w);
                    w.x = cvt_pk_bf16(s1[8], s1[9]); w.y = cvt_pk_bf16(s1[10], s1[11]); w.z = cvt_pk_bf16(s1[12], s1[13]); w.w = cvt_pk_bf16(s1[14], s1[15]); pf[3] = __builtin_bit_cast(bf16x8, w);
                }
                const LAS unsigned char* vb = buf + KBUF + l32 * VSTR + hi * 16;
#pragma unroll
                for (int d = 0; d < 4; ++d)
#pragma unroll
                    for (int ks = 0; ks < 4; ++ks) {
                        const bf16x8 vf = *(const LAS bf16x8*)(vb + d * 32 * VSTR + ks * 32);
                        o[d] = MFMA32(vf, pf[ks], o[d]);
                    }
            }
            if (t + 1 < ntiles) ATT_WRITE(lds + ((t + 1) & 1) * ABUF);
            __syncthreads();
        }
        if (active) {
            const float l = lsum + __shfl_xor(lsum, 32);
            const float inv = 1.0f / l;
            bf16_t* op = O + (size_t)(qrow0 + wid * 32 + l32) * DM + h * 128 + 4 * hi;
#pragma unroll
            for (int d = 0; d < 4; ++d)
#pragma unroll
                for (int g4 = 0; g4 < 4; ++g4) {
                    u32x2 w; w.x = cvt_pk_bf16(o[d][4 * g4] * inv, o[d][4 * g4 + 1] * inv); w.y = cvt_pk_bf16(o[d][4 * g4 + 2] * inv, o[d][4 * g4 + 3] * inv);
                    *(u32x2*)(op + d * 32 + 8 * g4) = w;
                }
        }
#undef ATT_LOAD
#undef ATT_WRITE
    }
}

__global__ void __launch_bounds__(NTHREADS, 2) yoco_fwd(Params p) {
    extern __shared__ __attribute__((aligned(16))) unsigned char lds_raw[];
    LAS unsigned char* lds = (LAS unsigned char*)lds_raw;
    cg::grid_group grid = cg::this_grid();
    const int G = gridDim.x, c = blockIdx.x;
    unsigned char* ws = p.ws;
    bf16_t* xb = (bf16_t*)(ws + WS_XB); bf16_t* Hb = (bf16_t*)(ws + WS_H);
    float* ssqb = (float*)(ws + WS_SSQ);
    float* xo = p.out;
    int cur = 0;

    for (int rep = 0; rep < DUP_P0; ++rep) { phase0(p, lds, G, c); if (rep + 1 < DUP_P0) __syncthreads(); }
    grid.sync();

    for (int l = 0; l < 4; ++l) {
        for (int hf = 0; hf < 2; ++hf) {
            if (hf == 1) {
                if (l < 2) {
#ifndef NO_PP
                    pool_prep(p, l, ssqb + (size_t)cur * 16 * T, lds, G, c);
#endif
                    grid.sync();
                    {
                        pg8::Gemm g{(const bf16_t*)(ws + WS_D), (const bf16_t*)(ws + WS_WPOOL) + (size_t)l * 1024 * 256, 256, 256, 256, T / 256, 4, (size_t)T * 256 * 2};
                        pg8::StaticOrder S; S.init(T / 256, 4, G, c);
                        pg8::EpiResid E{xo, xo + (size_t)TP * DM, xo, xb, ssqb + (size_t)(cur ^ 1) * 16 * T, p.in[13] + l * DM, 1.0f};
#ifndef NO_EPIRESID
                        pg8::gemm_phase<pg8::EpiResid>(lds, g, S, E);
#endif
                    }
                    cur ^= 1;
                    grid.sync();
                } else {
                    const int i = l - 2;
                    {
                        pg8::Gemm g{xb, (const bf16_t*)(ws + WS_WDQ) + (size_t)i * 512 * 1024, 1024, 1024, 1024, T / 256, 2, 0};
                        pg8::StaticOrder S; S.init(T / 256, 2, G, c);
                        pg8::EpiRawF32 E{(float*)(ws + WS_DQRAW), QL, QL, ssqb + (size_t)cur * 16 * T};
#ifndef NO_EPIRAWF32
                        pg8::gemm_phase<pg8::EpiRawF32>(lds, g, S, E);
#endif
                    }
                    grid.sync();
#ifndef NO_EW
                    qlat_norm(p, G, c);
#endif
                    grid.sync();
                    {
                        pg8::Gemm g{(const bf16_t*)(ws + WS_QLAT), (const bf16_t*)(ws + WS_WUQ) + (size_t)i * 1536 * 384, 384, 384, 384, T / 256, 6, 0};
                        pg8::StaticOrder S; S.init(T / 256, 6, G, c);
                        pg8::EpiRawBf16 E{(bf16_t*)(ws + WS_Q), HQ};
#ifndef NO_EPIRAWBF16
                        pg8::gemm_phase<pg8::EpiRawBf16>(lds, g, S, E);
#endif
                    }
                    grid.sync();
#ifndef NO_QA
                    q_assemble(p, i, G, c);
#endif
                    grid.sync();
                    for (int rep = 0; rep < DUP_ATT; ++rep) attn_phase(p, lds, G, c);
                    grid.sync();
                    {
                        pg8::Gemm g{(const bf16_t*)(ws + WS_O), (const bf16_t*)(ws + WS_WO) + (size_t)i * 1024 * 1024, 1024, 1024, 1024, T / 256, 4, 0};
                        pg8::StaticOrder S; S.init(T / 256, 4, G, c);
                        pg8::EpiResid E{xo, xo + (size_t)TP * DM, xo, xb, ssqb + (size_t)(cur ^ 1) * 16 * T, nullptr, 1.0f};
#ifndef NO_EPIRESID
                        pg8::gemm_phase<pg8::EpiResid>(lds, g, S, E);
#endif
                    }
                    cur ^= 1;
                    grid.sync();
                }
            }
            {
                pg8::Gemm g{xb, (const bf16_t*)(ws + WS_WIN + (size_t)(2 * l + hf) * SZ_WIN), 1024, 1024, 1024, T / 256, 22, 0};
                pg8::StaticOrder S; S.init(T / 256, 22, G, c);
                pg8::EpiSwiglu E{Hb, ssqb + (size_t)cur * 16 * T};
                for (int rep = 0; rep < DUP_FFNIN; ++rep) pg8::gemm_phase<pg8::EpiSwiglu>(lds, g, S, E);
            }
            grid.sync();
            {
                pg8::Gemm g{Hb, (const bf16_t*)(ws + WS_WOUT + (size_t)(2 * l + hf) * SZ_WOUT), FF, FF, FF, T / 256, 4, 0};
                pg8::StaticOrder S; S.init(T / 256, 4, G, c);
                const bool first = (l == 0 && hf == 0);
                pg8::EpiResid E{first ? p.in[0] : xo, first ? p.in[1] : xo + (size_t)TP * DM, xo, xb, ssqb + (size_t)(cur ^ 1) * 16 * T, nullptr, 0.5f};
#ifndef NO_EPIRESID
                pg8::gemm_phase<pg8::EpiResid>(lds, g, S, E);
#endif
            }
            cur ^= 1;
            grid.sync();
        }
        if (l == 1) {
            {
                pg8::Gemm g{xb, (const bf16_t*)(ws + WS_WDKV), 1024, 1024, 1024, T / 256, 2, 0};
                pg8::StaticOrder S; S.init(T / 256, 2, G, c);
                pg8::EpiRawF32 E{(float*)(ws + WS_LATRAW), LATW, LATW, ssqb + (size_t)cur * 16 * T};
#ifndef NO_EPIRAWF32
                pg8::gemm_phase<pg8::EpiRawF32>(lds, g, S, E);
#endif
            }
            grid.sync();
#ifndef NO_EW
            latent_norm(p, G, c);
#endif
            grid.sync();
            {
                pg8::Gemm g{(const bf16_t*)(ws + WS_CALL), (const bf16_t*)(ws + WS_WUK), 256, 256, 256, TALL / 256, 4, 0};
                pg8::StaticOrder S; S.init(TALL / 256, 4, G, c);
                pg8::EpiRawBf16 E{(bf16_t*)(ws + WS_KN), 1024};
#ifndef NO_EPIRAWBF16
                pg8::gemm_phase<pg8::EpiRawBf16>(lds, g, S, E);
#endif
            }
            {
                pg8::Gemm g{(const bf16_t*)(ws + WS_WUV), (const bf16_t*)(ws + WS_CALL), 256, 256, 256, 4, TALL / 256, 0};
                pg8::StaticOrder S; S.init(4, TALL / 256, G, c);
                pg8::EpiRawBf16 E{(bf16_t*)(ws + WS_VT), TALL};
#ifndef NO_EPIRAWBF16
                pg8::gemm_phase<pg8::EpiRawBf16>(lds, g, S, E);
#endif
            }
            grid.sync();
#ifndef NO_KA
            k_assemble(p, G, c);
#endif
            grid.sync();
        }
    }
}

extern "C" void kernel_launch(void* const* d_in, const int* in_sizes, int n_in, void* d_out, int out_size, void* d_ws, size_t ws_size, hipStream_t stream) {
    static int grid_blocks = 0;
    if (grid_blocks == 0) {
        if (n_in != 28 || ws_size < WS_END) { fprintf(stderr, "kernel_launch: unexpected n_in %d or ws_size %zu (need %zu)\n", n_in, ws_size, (size_t)WS_END); }
        int dev = 0, cus = 0, per_cu = 0;
        hipGetDevice(&dev);
        hipDeviceGetAttribute(&cus, hipDeviceAttributeMultiprocessorCount, dev);
        if (hipFuncSetAttribute((const void*)yoco_fwd, hipFuncAttributeMaxDynamicSharedMemorySize, LDS_BYTES) != hipSuccess) fprintf(stderr, "kernel_launch: hipFuncSetAttribute failed\n");
        if (hipOccupancyMaxActiveBlocksPerMultiprocessor(&per_cu, (const void*)yoco_fwd, NTHREADS, LDS_BYTES) != hipSuccess || per_cu < 1) { fprintf(stderr, "kernel_launch: occupancy query gave %d\n", per_cu); per_cu = 1; }
        (void)hipGetLastError();
        grid_blocks = cus * 1;
        if (grid_blocks <= 0) grid_blocks = 256;
    }
    Params p{};
    for (int i = 0; i < 28; ++i) p.in[i] = (const float*)d_in[i];
    p.out = (float*)d_out; p.ws = (unsigned char*)d_ws;
    void* args[] = {&p};
    hipError_t e = hipLaunchCooperativeKernel((const void*)yoco_fwd, dim3(grid_blocks), dim3(NTHREADS), args, LDS_BYTES, stream);
    if (e != hipSuccess) fprintf(stderr, "cooperative launch failed: %s (grid %d)\n", hipGetErrorString(e), grid_blocks);
}
```

```cpp
#include <hip/hip_runtime.h>
#include <hip/hip_cooperative_groups.h>
#include <cstdio>
#include <cstdint>
namespace cg = cooperative_groups;

#define LAS __attribute__((address_space(3)))
#ifndef DUP_FFNIN
#define DUP_FFNIN 1
#endif
#ifndef DUP_ATT
#define DUP_ATT 1
#endif
#ifndef DUP_SYNC
#define DUP_SYNC 1
#endif
#ifndef DUP_P0
#define DUP_P0 1
#endif
typedef unsigned short bf16_t;
typedef short bf16x8 __attribute__((ext_vector_type(8)));
typedef float f32x4 __attribute__((ext_vector_type(4)));
typedef float f32x2 __attribute__((ext_vector_type(2)));
typedef float f32x16 __attribute__((ext_vector_type(16)));
typedef unsigned u32x4 __attribute__((ext_vector_type(4)));
typedef unsigned u32x2 __attribute__((ext_vector_type(2)));

constexpr int DM = 1024, FF = 2816, TP = 65536, TS = 256, T = TP + TS, SEQ = 2048, NBATCH = 32, DBATCH = 8, DSEQ = 32, PAST = 1024;
constexpr int SKEY = 1088;
constexpr int TALL = TP + DBATCH * SKEY;
constexpr int KVL = 256, QL = 384, HQ = 1536, NH = 8, LATW = 320;
constexpr float EPS = 1e-6f;
constexpr int NTHREADS = 512;
constexpr int LDS_BYTES = 131072 + 1024;

constexpr size_t OUT_Y = 0;
constexpr size_t OUT_POOL_P = (size_t)T * DM;
constexpr size_t OUT_POOL_S = OUT_POOL_P + (size_t)2 * 32 * 15 * 1024;
constexpr size_t OUT_CKV_P = OUT_POOL_S + (size_t)2 * 8 * 15 * 1024;
constexpr size_t OUT_KR_P = OUT_CKV_P + (size_t)TP * 256;
constexpr size_t OUT_CKV_S = OUT_KR_P + (size_t)TP * 64;
constexpr size_t OUT_KR_S = OUT_CKV_S + (size_t)TS * 256;

constexpr size_t SZ_WIN = (size_t)5632 * 1024 * 2, SZ_WOUT = (size_t)1024 * 2816 * 2;
constexpr size_t WS_WIN = 0;
constexpr size_t WS_WOUT = WS_WIN + 8 * SZ_WIN;
constexpr size_t WS_WPOOL = WS_WOUT + 8 * SZ_WOUT;
constexpr size_t WS_WDKV = WS_WPOOL + (size_t)2 * 1024 * 256 * 2;
constexpr size_t WS_WUK = WS_WDKV + (size_t)512 * 1024 * 2;
constexpr size_t WS_WUV = WS_WUK + (size_t)1024 * 256 * 2;
constexpr size_t WS_WDQ = WS_WUV + (size_t)1024 * 256 * 2;
constexpr size_t WS_WUQ = WS_WDQ + (size_t)2 * 512 * 1024 * 2;
constexpr size_t WS_WO = WS_WUQ + (size_t)2 * 1536 * 384 * 2;
constexpr size_t WS_XB = WS_WO + (size_t)2 * 1024 * 1024 * 2;
constexpr size_t WS_H = WS_XB + (size_t)T * 1024 * 2;
constexpr size_t SZ_H = (size_t)T * FF * 2;
constexpr size_t WS_D = WS_H;
constexpr size_t WS_LATRAW = WS_H;
constexpr size_t WS_CALL = WS_H + (size_t)T * LATW * 4;
constexpr size_t WS_Q = WS_H;
constexpr size_t WS_O = WS_H + (size_t)T * HQ * 2;
constexpr size_t WS_DQRAW = WS_O;
constexpr size_t WS_KN = WS_H + SZ_H;
constexpr size_t WS_VT = WS_KN + (size_t)TALL * 1024 * 2;
constexpr size_t WS_KR = WS_VT + (size_t)TALL * 1024 * 2;
constexpr size_t WS_QLAT = WS_KR + (size_t)TALL * 64 * 2;
constexpr size_t WS_SSQ = WS_QLAT + (size_t)T * QL * 2;
constexpr size_t WS_ROPE = WS_SSQ + (size_t)2 * 16 * T * 4;
constexpr size_t WS_BAR = WS_ROPE + (size_t)2 * 2048 * 32 * 4;
constexpr size_t WS_END = WS_BAR + 16384;
static_assert(WS_O + (size_t)T * 1024 * 2 <= WS_H + SZ_H, "Q+O overlay");
static_assert(WS_CALL + (size_t)TALL * 256 * 2 <= WS_H + SZ_H, "latent overlay");
static_assert(WS_END <= (size_t)1 << 30, "workspace");

struct Params {
    const float* in[28];
    float* out;
    unsigned char* ws;
};

typedef __bf16 bf16x2_t __attribute__((ext_vector_type(2)));
__device__ __forceinline__ unsigned cvt_pk_bf16(float lo, float hi) { const f32x2 v = {lo, hi}; const bf16x2_t r = __builtin_convertvector(v, bf16x2_t); return __builtin_bit_cast(unsigned, r); }
__device__ __forceinline__ float bf2f(unsigned short b) { return __uint_as_float(((unsigned)b) << 16); }
__device__ __forceinline__ float bflo(unsigned w) { return __uint_as_float(w << 16); }
__device__ __forceinline__ float bfhi(unsigned w) { return __uint_as_float(w & 0xffff0000u); }
__device__ __forceinline__ float fast_rsqrt(float x) { return 1.0f / sqrtf(x); }
__device__ __forceinline__ float silu_mul(float g, float u) { return g * __builtin_amdgcn_rcpf(1.0f + __builtin_amdgcn_exp2f(-1.4426950408889634f * g)) * u; }

namespace pg8 {
constexpr int BM = 256, BK = 64, HALF = 128, HTB = HALF * BK * 2, STAGE_BYTES = 8 * HTB, NXCD = 8, WGM = 8;
__device__ __forceinline__ int lds_byte(int r, int c) { const int st = (r >> 4) * 2 + (c >> 5), rr = r & 15, cc = c & 31, ob = rr * 64 + cc * 2; return st * 1024 + (ob ^ (((ob >> 9) & 1) << 5)); }
__device__ __forceinline__ void stage_rc(int b, int& R, int& C) { const int st = b / 1024, sb = b % 1024, swz = sb ^ (((sb >> 9) & 1) << 5); R = (st >> 1) * 16 + swz / 64; C = (st & 1) * 32 + (swz % 64) / 2; }
__device__ __forceinline__ int perm32(int rho) { const int n = rho >> 4, i = rho & 15; return 8 * (i >> 2) + 4 * n + (i & 3); }

struct Unit { int pm, pn; };
struct Gemm { const bf16_t* A; const bf16_t* Bt; int lda, ldb, K, nM, nN; size_t a_pn_stride; };

struct StaticOrder {
    int nM, nN, nwg, G, c;
    __device__ void init(int nM_, int nN_, int G_, int c_) { nM = nM_; nN = nN_; nwg = nM * nN; G = G_; c = c_; }
    __device__ bool next(int i, Unit& u) const {
        const long L = (long)i * G + c; if (L >= nwg) return false;
        int wgid = (int)L; { const int q = nwg / NXCD, r = nwg % NXCD, xcd = wgid % NXCD, off = wgid / NXCD; wgid = (xcd < r ? xcd * (q + 1) : r * (q + 1) + (xcd - r) * q) + off; }
        const int nig = WGM * nN, gid = wgid / nig, fm = gid * WGM, gsz = (nM - fm) < WGM ? (nM - fm) : WGM;
        u.pm = fm + ((wgid % nig) % gsz); u.pn = (wgid % nig) / gsz; return true;
    }
};


__device__ __forceinline__ float row_rstd(const float* ssq, int row, int fq) {
    float s = 0.f;
#pragma unroll
    for (int j = 0; j < 4; ++j) s += ssq[(size_t)(4 * fq + j) * T + row];
    s += __shfl_xor(s, 16); s += __shfl_xor(s, 32);
    return fast_rsqrt(s * (1.0f / 1024.0f) + EPS);
}

struct EpiSwiglu {
    static constexpr bool PERM = true;
    bf16_t* H; const float* ssq;
    __device__ __forceinline__ void operator()(const f32x4 (&acc)[2][2][4][2], const Unit& u, int wr, int wc, int fr_, int fq_) const {
        int fr = fr_, fq = fq_; asm volatile("" : "+v"(fr), "+v"(fq));
        const int row0 = u.pm * BM + wr * 64 + fr;
#pragma unroll
        for (int ai = 0; ai < 2; ++ai)
#pragma unroll
            for (int m = 0; m < 4; ++m) {
                const int row = row0 + ai * HALF + m * 16;
                const float r = row_rstd(ssq, row, fq);
                const f32x4 g0 = acc[ai][0][m][0] * r, g1 = acc[ai][0][m][1] * r, u0 = acc[ai][1][m][0] * r, u1 = acc[ai][1][m][1] * r;
                u32x4 w;
                w.x = cvt_pk_bf16(silu_mul(g0[0], u0[0]), silu_mul(g0[1], u0[1]));
                w.y = cvt_pk_bf16(silu_mul(g0[2], u0[2]), silu_mul(g0[3], u0[3]));
                w.z = cvt_pk_bf16(silu_mul(g1[0], u1[0]), silu_mul(g1[1], u1[1]));
                w.w = cvt_pk_bf16(silu_mul(g1[2], u1[2]), silu_mul(g1[3], u1[3]));
                *(u32x4*)(H + (size_t)row * FF + u.pn * 128 + wc * 32 + 8 * fq) = w;
            }
    }
};

struct EpiResid {
    static constexpr bool PERM = false;
    const float* res0; const float* res1; float* out; bf16_t* xb; float* ssq; const float* colscale; float cs;
    __device__ __forceinline__ void operator()(const f32x4 (&acc)[2][2][4][2], const Unit& u, int wr, int wc, int fr_, int fq_) const {
        int fr = fr_, fq = fq_; asm volatile("" : "+v"(fr), "+v"(fq));
        const int row0 = u.pm * BM + wr * 64 + fr;
#pragma unroll
        for (int ai = 0; ai < 2; ++ai)
#pragma unroll
            for (int m = 0; m < 4; ++m) {
                const int row = row0 + ai * HALF + m * 16;
                const float* rp = (row < TP) ? res0 + (size_t)row * DM : res1 + (size_t)(row - TP) * DM;
                float sq = 0.f;
#pragma unroll
                for (int bj = 0; bj < 2; ++bj)
#pragma unroll
                    for (int n = 0; n < 2; ++n) {
                        const int col = u.pn * BM + bj * HALF + wc * 32 + n * 16 + 4 * fq;
                        const f32x4 rv = *(const f32x4*)(rp + col);
                        f32x4 sc = (f32x4){cs, cs, cs, cs};
                        if (colscale) sc = *(const f32x4*)(colscale + col);
                        const f32x4 v = rv + acc[ai][bj][m][n] * sc;
                        *(f32x4*)(out + (size_t)row * DM + col) = v;
                        u32x2 w; w.x = cvt_pk_bf16(v[0], v[1]); w.y = cvt_pk_bf16(v[2], v[3]);
                        *(u32x2*)(xb + (size_t)row * DM + col) = w;
                        sq += (v[0] * v[0] + v[1] * v[1]) + (v[2] * v[2] + v[3] * v[3]);
                    }
                sq += __shfl_xor(sq, 16); sq += __shfl_xor(sq, 32);
                if (fq == 0) ssq[(size_t)(u.pn * 4 + wc) * T + row] = sq;
            }
    }
};

struct EpiRawF32 {
    static constexpr bool PERM = false;
    float* O; int ldc; int ncols; const float* ssq;
    __device__ __forceinline__ void operator()(const f32x4 (&acc)[2][2][4][2], const Unit& u, int wr, int wc, int fr_, int fq_) const {
        int fr = fr_, fq = fq_; asm volatile("" : "+v"(fr), "+v"(fq));
        const int row0 = u.pm * BM + wr * 64 + fr;
#pragma unroll
        for (int ai = 0; ai < 2; ++ai)
#pragma unroll
            for (int m = 0; m < 4; ++m) {
                const int row = row0 + ai * HALF + m * 16;
                const float r = row_rstd(ssq, row, fq);
#pragma unroll
                for (int bj = 0; bj < 2; ++bj)
#pragma unroll
                    for (int n = 0; n < 2; ++n) {
                        const int col = u.pn * BM + bj * HALF + wc * 32 + n * 16 + 4 * fq;
                        if (col < ncols) *(f32x4*)(O + (size_t)row * ldc + col) = acc[ai][bj][m][n] * r;
                    }
            }
    }
};

struct EpiRawBf16 {
    static constexpr bool PERM = true;
    bf16_t* O; int ldc;
    __device__ __forceinline__ void operator()(const f32x4 (&acc)[2][2][4][2], const Unit& u, int wr, int wc, int fr_, int fq_) const {
        int fr = fr_, fq = fq_; asm volatile("" : "+v"(fr), "+v"(fq));
        const int row0 = u.pm * BM + wr * 64 + fr;
#pragma unroll
        for (int ai = 0; ai < 2; ++ai)
#pragma unroll
            for (int m = 0; m < 4; ++m) {
                bf16_t* rowp = O + (size_t)(row0 + ai * HALF + m * 16) * ldc + u.pn * BM + wc * 32 + 8 * fq;
#pragma unroll
                for (int bj = 0; bj < 2; ++bj) {
                    const f32x4 v0 = acc[ai][bj][m][0], v1 = acc[ai][bj][m][1];
                    u32x4 w; w.x = cvt_pk_bf16(v0[0], v0[1]); w.y = cvt_pk_bf16(v0[2], v0[3]); w.z = cvt_pk_bf16(v1[0], v1[1]); w.w = cvt_pk_bf16(v1[2], v1[3]);
                    *(u32x4*)(rowp + bj * HALF) = w;
                }
            }
    }
};

template <class Epi>
__device__ __forceinline__ void gemm_phase(LAS unsigned char* lds, const Gemm g, const StaticOrder& S, const Epi& E) {
    int tid = threadIdx.x; asm volatile("" : "+v"(tid));
    const int wid = __builtin_amdgcn_readfirstlane(tid >> 6), lane = tid & 63, wr = wid >> 2, wc = wid & 3, fr = lane & 15, fq = lane >> 4;
    const int K = g.K, nt = K / BK;
    unsigned voffA[2], voffB[2];
#pragma unroll
    for (int i = 0; i < 2; ++i) { int R, C; stage_rc(tid * 16 + i * 8192, R, C); const int Rb = Epi::PERM ? ((R & ~31) + perm32(R & 31)) : R;
        voffA[i] = (unsigned)(R * g.lda + C) * 2u; voffB[i] = (unsigned)(Rb * g.ldb + C) * 2u; }
    const size_t kstep = (size_t)(BK * 2);
    const size_t hA = (size_t)HALF * g.lda * 2, hB = (size_t)HALF * g.ldb * 2;
    const size_t tA = 2 * hA, tB = 2 * hB;
    const unsigned ldsw = (unsigned)wid * 1024u;
    const int aoff = lds_byte(wr * 64 + fr, fq * 8), boff = lds_byte(wc * 32 + fr, fq * 8);
#define PG8_SA(b, h) (((b) * 2 + (h)) * HTB)
#define PG8_SB(b, h) ((4 + (b) * 2 + (h)) * HTB)
#define PG8_STAGE(bufoff, gbase, voff) do { _Pragma("unroll") for (int _i = 0; _i < 2; ++_i) \
        __builtin_amdgcn_global_load_lds((const unsigned*)((const char*)(gbase) + (voff)[_i]), (LAS unsigned*)(lds + (bufoff) + ldsw + _i * 8192), 16, 0, 0); } while (0)
#define PG8_LDA(dst, b, h) do { _Pragma("unroll") for (int m = 0; m < 4; ++m) _Pragma("unroll") for (int k = 0; k < 2; ++k) dst[m][k] = *(const LAS bf16x8*)(lds + PG8_SA(b, h) + aoff + m * 2048 + k * 1024); } while (0)
#define PG8_LDB(dst, b, h) do { _Pragma("unroll") for (int n = 0; n < 2; ++n) _Pragma("unroll") for (int k = 0; k < 2; ++k) dst[n][k] = *(const LAS bf16x8*)(lds + PG8_SB(b, h) + boff + n * 2048 + k * 1024); } while (0)
#define PG8_MMA(ai, bj, At, Bt) do { __builtin_amdgcn_s_setprio(1); _Pragma("unroll") for (int m = 0; m < 4; ++m) _Pragma("unroll") for (int n = 0; n < 2; ++n) _Pragma("unroll") for (int k = 0; k < 2; ++k) \
        acc[ai][bj][m][n] = __builtin_amdgcn_mfma_f32_16x16x32_bf16(Bt[n][k], At[m][k], acc[ai][bj][m][n], 0, 0, 0); __builtin_amdgcn_s_setprio(0); } while (0)
#define PG8_WAIT_V(n) asm volatile("s_waitcnt vmcnt(" #n ")" ::: "memory")
#define PG8_WAIT_L(n) asm volatile("s_waitcnt lgkmcnt(" #n ")" ::: "memory")
#define PG8_BAR __builtin_amdgcn_s_barrier()
#define PG8_SCHED __builtin_amdgcn_sched_barrier(0)
    Unit cur, nxt; int ui = 0;
    if (!S.next(0, cur)) return;
    f32x4 acc[2][2][4][2];
#pragma unroll
    for (int a = 0; a < 2; ++a)
#pragma unroll
        for (int b = 0; b < 2; ++b)
#pragma unroll
            for (int m = 0; m < 4; ++m)
#pragma unroll
                for (int n = 0; n < 2; ++n) acc[a][b][m][n] = (f32x4){0.f, 0.f, 0.f, 0.f};
    bf16x8 At[4][2], B0[2][2], B1[2][2];
    const char* cA = (const char*)g.A + (size_t)cur.pm * tA + (size_t)cur.pn * g.a_pn_stride; const char* cB = (const char*)g.Bt + (size_t)cur.pn * tB;
    PG8_STAGE(PG8_SB(0, 0), cB, voffB); PG8_STAGE(PG8_SB(0, 1), cB + hB, voffB); PG8_STAGE(PG8_SA(0, 0), cA, voffA); PG8_STAGE(PG8_SA(0, 1), cA + hA, voffA);
    if (wr == 1) PG8_BAR;
    PG8_WAIT_V(2); PG8_BAR;
    PG8_STAGE(PG8_SB(1, 0), cB + kstep, voffB); PG8_STAGE(PG8_SA(1, 0), cA + kstep, voffA); PG8_STAGE(PG8_SB(1, 1), cB + hB + kstep, voffB);
    PG8_WAIT_V(6); PG8_BAR;
    for (;;) {
        const bool has_next = S.next(ui + 1, nxt);
        const char* nA = has_next ? (const char*)g.A + (size_t)nxt.pm * tA + (size_t)nxt.pn * g.a_pn_stride : cA; const char* nB = has_next ? (const char*)g.Bt + (size_t)nxt.pn * tB : cB;
        for (int t = 0; t < nt; t += 2) {
            const bool last = (t == nt - 2);
            const char* a1 = cA + (size_t)(t + 1) * kstep;
            const char* a2 = last ? nA : cA + (size_t)(t + 2) * kstep; const char* b2 = last ? nB : cB + (size_t)(t + 2) * kstep;
            const char* a3 = a2 + kstep; const char* b3 = b2 + kstep;
            PG8_LDB(B0, 0, 0); PG8_LDB(B1, 0, 1); PG8_SCHED; PG8_LDA(At, 0, 0); PG8_STAGE(PG8_SA(1, 1), a1 + hA, voffA);
            PG8_WAIT_V(8); PG8_WAIT_L(0); PG8_BAR; PG8_MMA(0, 0, At, B0); PG8_MMA(0, 1, At, B1); PG8_BAR; PG8_SCHED;
            PG8_LDA(At, 0, 1); PG8_STAGE(PG8_SB(0, 0), b2, voffB); PG8_STAGE(PG8_SB(0, 1), b2 + hB, voffB); PG8_STAGE(PG8_SA(0, 0), a2, voffA);
            PG8_WAIT_V(8); PG8_WAIT_L(0); PG8_BAR; PG8_MMA(1, 0, At, B0); PG8_MMA(1, 1, At, B1); PG8_BAR; PG8_SCHED;
            PG8_LDB(B0, 1, 0); PG8_LDB(B1, 1, 1); PG8_SCHED; PG8_LDA(At, 1, 0); PG8_STAGE(PG8_SA(0, 1), a2 + hA, voffA);
            PG8_WAIT_V(8); PG8_WAIT_L(0); PG8_BAR; PG8_MMA(0, 0, At, B0); PG8_MMA(0, 1, At, B1); PG8_BAR; PG8_SCHED;
            PG8_LDA(At, 1, 1); PG8_STAGE(PG8_SB(1, 0), b3, voffB); PG8_STAGE(PG8_SB(1, 1), b3 + hB, voffB); PG8_STAGE(PG8_SA(1, 0), a3, voffA);
            PG8_WAIT_V(8); PG8_WAIT_L(0); PG8_BAR; PG8_MMA(1, 0, At, B0); PG8_MMA(1, 1, At, B1); PG8_BAR; PG8_SCHED;
        }
        if (wr == 0) PG8_BAR;
        E(acc, cur, wr, wc, fr, fq);
        if (!has_next) break;
#pragma unroll
        for (int a = 0; a < 2; ++a)
#pragma unroll
            for (int b = 0; b < 2; ++b)
#pragma unroll
                for (int m = 0; m < 4; ++m)
#pragma unroll
                    for (int n = 0; n < 2; ++n) acc[a][b][m][n] = (f32x4){0.f, 0.f, 0.f, 0.f};
        cur = nxt; cA = nA; cB = nB; ++ui;
        if (wr == 1) PG8_BAR;
    }
    PG8_WAIT_V(0);
    PG8_BAR;
#undef PG8_SA
#undef PG8_SB
#undef PG8_STAGE
#undef PG8_LDA
#undef PG8_LDB
#undef PG8_MMA
#undef PG8_WAIT_V
#undef PG8_WAIT_L
#undef PG8_BAR
#undef PG8_SCHED
}
}

__device__ __forceinline__ float wave_sum(float v) {
#pragma unroll
    for (int o = 1; o < 64; o <<= 1) v += __shfl_xor(v, o);
    return v;
}
__device__ __forceinline__ void conv_weight(const float* W, int K, int N, bf16_t* WT, const float* gain, int mode, int row_off, LAS float* scr, int gw, int NGW, int lane) {
    const int nblk = N / 32, nitems = (K / 64) * nblk;
    for (int item = gw; item < nitems; item += NGW) {
        const int kb = item / nblk, nb = item % nblk, k0 = 64 * kb, n0 = 32 * nb;
#pragma unroll 8
        for (int i = 0; i < 32; ++i) { const int kk = 2 * i + (lane >> 5); float v = W[(size_t)(k0 + kk) * N + n0 + (lane & 31)]; if (gain) v *= gain[k0 + kk]; scr[kk * 33 + (lane & 31)] = v; }
        asm volatile("s_waitcnt lgkmcnt(0)" ::: "memory");
        const int c = lane & 7;
#pragma unroll
        for (int j = 0; j < 4; ++j) {
            const int n = (lane >> 3) + 8 * j; const LAS float* s = scr + (8 * c) * 33 + n;
            u32x4 o; o.x = cvt_pk_bf16(s[0 * 33], s[1 * 33]); o.y = cvt_pk_bf16(s[2 * 33], s[3 * 33]); o.z = cvt_pk_bf16(s[4 * 33], s[5 * 33]); o.w = cvt_pk_bf16(s[6 * 33], s[7 * 33]);
            const int na = n0 + n; int row;
            if (mode == 1) { const int up = na >= FF ? 1 : 0; const int jn = na - up * FF; row = 256 * (jn >> 7) + 128 * up + (jn & 127); }
            else row = row_off + na;
            *(u32x4*)(WT + (size_t)row * K + k0 + 8 * c) = o;
        }
        asm volatile("s_waitcnt lgkmcnt(0)" ::: "memory");
    }
}

__device__ __forceinline__ void phase0(const Params& p, LAS unsigned char* lds, int G, int c) {
    int tid = threadIdx.x; asm volatile("" : "+v"(tid));
    const int lane = tid & 63, wave = tid >> 6;
    LAS float* scr = (LAS float*)(lds + wave * 8704);
    const int gw = c * 8 + wave, NGW = G * 8;
    unsigned char* ws = p.ws;
    for (int l = 0; l < 4; ++l) {
        conv_weight(p.in[6] + (size_t)l * 1024 * 5632, 1024, 5632, (bf16_t*)(ws + WS_WIN + (size_t)(2 * l) * SZ_WIN), p.in[5] + l * 1024, 1, 0, scr, gw, NGW, lane);
        conv_weight(p.in[10] + (size_t)l * 1024 * 5632, 1024, 5632, (bf16_t*)(ws + WS_WIN + (size_t)(2 * l + 1) * SZ_WIN), p.in[9] + l * 1024, 1, 0, scr, gw, NGW, lane);
        conv_weight(p.in[7] + (size_t)l * 2816 * 1024, 2816, 1024, (bf16_t*)(ws + WS_WOUT + (size_t)(2 * l) * SZ_WOUT), nullptr, 0, 0, scr, gw, NGW, lane);
        conv_weight(p.in[11] + (size_t)l * 2816 * 1024, 2816, 1024, (bf16_t*)(ws + WS_WOUT + (size_t)(2 * l + 1) * SZ_WOUT), nullptr, 0, 0, scr, gw, NGW, lane);
    }
    for (int lg = 0; lg < 8; ++lg)
        conv_weight(p.in[12] + (size_t)lg * 65536, 256, 256, (bf16_t*)(ws + WS_WPOOL) + (size_t)(lg >> 2) * 1024 * 256, nullptr, 0, (lg & 3) * 256, scr, gw, NGW, lane);
    conv_weight(p.in[15], 1024, 256, (bf16_t*)(ws + WS_WDKV), p.in[14], 0, 0, scr, gw, NGW, lane);
    conv_weight(p.in[17], 1024, 64, (bf16_t*)(ws + WS_WDKV), p.in[14], 0, 256, scr, gw, NGW, lane);
    conv_weight(p.in[19], 256, 1024, (bf16_t*)(ws + WS_WUK), nullptr, 0, 0, scr, gw, NGW, lane);
    conv_weight(p.in[21], 256, 1024, (bf16_t*)(ws + WS_WUV), nullptr, 0, 0, scr, gw, NGW, lane);
    for (int i = 0; i < 2; ++i) {
        conv_weight(p.in[22] + (size_t)i * 1024 * 384, 1024, 384, (bf16_t*)(ws + WS_WDQ) + (size_t)i * 512 * 1024, p.in[8] + (2 + i) * 1024, 0, 0, scr, gw, NGW, lane);
        conv_weight(p.in[24] + (size_t)i * 384 * 1536, 384, 1536, (bf16_t*)(ws + WS_WUQ) + (size_t)i * 1536 * 384, p.in[23] + i * 384, 0, 0, scr, gw, NGW, lane);
        conv_weight(p.in[27] + (size_t)i * 1024 * 1024, 1024, 1024, (bf16_t*)(ws + WS_WO) + (size_t)i * 1024 * 1024, nullptr, 0, 0, scr, gw, NGW, lane);
    }
    {
        const int gt = c * NTHREADS + tid, NGT = G * NTHREADS;
        const u32x4 z = (u32x4){0u, 0u, 0u, 0u};
        u32x4* d0 = (u32x4*)((bf16_t*)(ws + WS_WDKV) + (size_t)320 * 1024);
        for (int i = gt; i < 192 * 1024 / 8; i += NGT) d0[i] = z;
        for (int q = 0; q < 2; ++q) { u32x4* d1 = (u32x4*)((bf16_t*)(ws + WS_WDQ) + (size_t)q * 512 * 1024 + (size_t)384 * 1024);
            for (int i = gt; i < 128 * 1024 / 8; i += NGT) d1[i] = z; }
        float* ct = (float*)(ws + WS_ROPE); float* st = ct + 2048 * 32;
        for (int i = gt; i < 2048 * 32; i += NGT) {
            const int pos = i >> 5, j = i & 31;
            const float inv = exp2f(-(float)j * 0.41524101186092029f);
            const float rev = (float)pos * inv * 0.15915494309189535f;
            const float fr = rev - floorf(rev);
            ct[i] = __builtin_amdgcn_cosf(fr); st[i] = __builtin_amdgcn_sinf(fr);
        }
    }
    {
        bf16_t* xb = (bf16_t*)(ws + WS_XB); float* ssq = (float*)(ws + WS_SSQ);
        for (int row = gw; row < T; row += NGW) {
            const float* xr = (row < TP) ? p.in[0] + (size_t)row * DM : p.in[1] + (size_t)(row - TP) * DM;
            float s = 0.f;
#pragma unroll
            for (int j = 0; j < 4; ++j) {
                const f32x4 v = *(const f32x4*)(xr + 4 * lane + 256 * j);
                s += (v[0] * v[0] + v[1] * v[1]) + (v[2] * v[2] + v[3] * v[3]);
                u32x2 w; w.x = cvt_pk_bf16(v[0], v[1]); w.y = cvt_pk_bf16(v[2], v[3]);
                *(u32x2*)(xb + (size_t)row * DM + 4 * lane + 256 * j) = w;
            }
            s = wave_sum(s);
            if (lane < 16) ssq[(size_t)lane * T + row] = (lane == 0) ? s : 0.f;
        }
    }
}

template <int W>
__device__ __forceinline__ void pool_item(const float* x, const float* prev, bool samp, int rowbase, int s0, int S, int start, int col, int grp, f32x2 g2,
                                          const LAS float* lrs, bf16_t* Dp, float* opool) {
    f32x2 h[31 + W];
#pragma unroll
    for (int j = -(W - 1); j < 32; ++j) {
        const int s = s0 + j;
        const float* src = (s >= 0) ? x + (size_t)(rowbase + s) * DM + col : (samp ? prev + (size_t)(15 + s) * DM + col : x + (size_t)rowbase * DM + col);
        h[j + W - 1] = *(const f32x2*)src;
    }
#pragma unroll
    for (int j = -(W - 1); j < 32; ++j) {
        const int s = s0 + j;
        f32x2 sc;
        if (s >= 0) { const float r = lrs[j + 15]; sc = (f32x2){r * g2.x, r * g2.y}; }
        else sc = samp ? (f32x2){1.f, 1.f} : (f32x2){0.f, 0.f};
        h[j + W - 1] = h[j + W - 1] * sc;
    }
    f32x2 sum = (f32x2){0.f, 0.f};
#pragma unroll
    for (int j = 0; j < W - 1; ++j) sum += h[j];
#pragma unroll
    for (int j = 0; j < 32; ++j) {
        const int s = s0 + j;
        const f32x2 hs = h[j + W - 1]; sum += hs;
        const int pos = start + s; const int cnt = (pos + 1 < W) ? pos + 1 : W;
        const float ic = 1.0f / (float)cnt;
        const f32x2 d = (f32x2){sum.x * ic - hs.x, sum.y * ic - hs.y};
        *(unsigned*)(Dp + ((size_t)grp * T + rowbase + s) * 256 + (col & 255)) = cvt_pk_bf16(d.x, d.y);
        if (s >= S - 15) *(f32x2*)(opool + (size_t)(s - (S - 15)) * DM + col) = hs;
        sum -= h[j];
    }
}
__device__ __forceinline__ void pool_prep(const Params& p, int layer, const float* ssq, LAS unsigned char* lds, int G, int c) {
    int tid = threadIdx.x; asm volatile("" : "+v"(tid));
    LAS float* lrs = (LAS float*)lds;
    const float* x = p.out;
    const float* gain = p.in[8] + layer * DM;
    bf16_t* Dp = (bf16_t*)(p.ws + WS_D);
    const int col = 2 * tid, grp = __builtin_amdgcn_readfirstlane(tid >> 7);
    const f32x2 g2 = *(const f32x2*)(gain + col);
    for (int item = c; item < 2048 + 8; item += G) {
        const bool samp = item >= 2048;
        int b, s0, S, rowbase, start;
        if (!samp) { b = item >> 6; s0 = (item & 63) * 32; rowbase = b * SEQ; S = SEQ; start = 0; }
        else { b = item - 2048; s0 = 0; rowbase = TP + b * DSEQ; S = DSEQ; start = PAST; }
        if (tid < 47) {
            const int s = s0 - 15 + tid; float r = 0.f;
            if (s >= 0) { const int row = rowbase + s; float sum = 0.f;
#pragma unroll
                for (int j = 0; j < 16; ++j) sum += ssq[(size_t)j * T + row];
                r = fast_rsqrt(sum * (1.0f / 1024.0f) + EPS); }
            lrs[tid] = r;
        }
        __syncthreads();
        const float* prev = p.in[2] + ((size_t)(layer * DBATCH + b) * 15) * DM;
        float* opool = samp ? p.out + OUT_POOL_S + ((size_t)(layer * DBATCH + b) * 15) * DM : p.out + OUT_POOL_P + ((size_t)(layer * NBATCH + b) * 15) * DM;
        if (grp == 0) pool_item<2>(x, prev, samp, rowbase, s0, S, start, col, grp, g2, lrs, Dp, opool);
        else if (grp == 1) pool_item<4>(x, prev, samp, rowbase, s0, S, start, col, grp, g2, lrs, Dp, opool);
        else if (grp == 2) pool_item<8>(x, prev, samp, rowbase, s0, S, start, col, grp, g2, lrs, Dp, opool);
        else pool_item<16>(x, prev, samp, rowbase, s0, S, start, col, grp, g2, lrs, Dp, opool);
        __syncthreads();
    }
}

__device__ __forceinline__ void latent_norm(const Params& p, int G, int c) {
    int tid = threadIdx.x; asm volatile("" : "+v"(tid));
    const int lane = tid & 63, wave = tid >> 6;
    const int gw = c * 8 + wave, NGW = G * 8;
    const float* raw = (const float*)(p.ws + WS_LATRAW);
    bf16_t* call = (bf16_t*)(p.ws + WS_CALL); bf16_t* krb = (bf16_t*)(p.ws + WS_KR);
    const float* ct = (const float*)(p.ws + WS_ROPE); const float* st = ct + 2048 * 32;
    const f32x4 cg4 = *(const f32x4*)(p.in[16] + 4 * lane);
    const float kg = p.in[18][lane];
    for (int row = gw; row < T; row += NGW) {
        const float* rr = raw + (size_t)row * LATW;
        const f32x4 v = *(const f32x4*)(rr + 4 * lane);
        const float kv = rr[256 + lane];
        const float sc = wave_sum((v[0] * v[0] + v[1] * v[1]) + (v[2] * v[2] + v[3] * v[3]));
        const float sk = wave_sum(kv * kv);
        const float rc = fast_rsqrt(sc * (1.0f / 256.0f) + EPS), rk = fast_rsqrt(sk * (1.0f / 64.0f) + EPS);
        const f32x4 cv = (f32x4){v[0] * rc * cg4[0], v[1] * rc * cg4[1], v[2] * rc * cg4[2], v[3] * rc * cg4[3]};
        const float kn = kv * rk * kg;
        int pos, krow; float* oc; float* ok;
        if (row < TP) { pos = row & (SEQ - 1); krow = row; oc = p.out + OUT_CKV_P + (size_t)row * 256; ok = p.out + OUT_KR_P + (size_t)row * 64; }
        else { const int r2 = row - TP, b = r2 >> 5, s = r2 & 31; pos = PAST + s; krow = TP + b * SKEY + PAST + s; oc = p.out + OUT_CKV_S + (size_t)r2 * 256; ok = p.out + OUT_KR_S + (size_t)r2 * 64; }
        const float other = __shfl_xor(kn, 32);
        const float cs = ct[pos * 32 + (lane & 31)], sn = st[pos * 32 + (lane & 31)];
        const float ko = (lane < 32) ? (kn * cs - other * sn) : (kn * cs + other * sn);
        *(f32x4*)(oc + 4 * lane) = cv;
        ok[lane] = ko;
        u32x2 w; w.x = cvt_pk_bf16(cv[0], cv[1]); w.y = cvt_pk_bf16(cv[2], cv[3]);
        *(u32x2*)(call + (size_t)krow * 256 + 4 * lane) = w;
        const float kon = __shfl_down(ko, 1);
        if ((lane & 1) == 0) *(unsigned*)(krb + (size_t)krow * 64 + lane) = cvt_pk_bf16(ko, kon);
    }
    for (int r = gw; r < DBATCH * SKEY; r += NGW) {
        const int b = r / SKEY, t = r % SKEY; const int krow = TP + r;
        if (t >= PAST && t < PAST + DSEQ) continue;
        u32x2 w = (u32x2){0u, 0u}; unsigned kw = 0u;
        if (t < PAST) {
            const f32x4 v = *(const f32x4*)(p.in[3] + ((size_t)b * PAST + t) * 256 + 4 * lane);
            w.x = cvt_pk_bf16(v[0], v[1]); w.y = cvt_pk_bf16(v[2], v[3]);
            if (lane < 32) { const f32x2 k2 = *(const f32x2*)(p.in[4] + ((size_t)b * PAST + t) * 64 + 2 * lane); kw = cvt_pk_bf16(k2.x, k2.y); }
        }
        *(u32x2*)(call + (size_t)krow * 256 + 4 * lane) = w;
        if (lane < 32) *(unsigned*)(krb + (size_t)krow * 64 + 2 * lane) = kw;
    }
}

__device__ __forceinline__ void unpack16(const u32x4 a, const u32x4 b, float (&v)[16]) {
    v[0] = bflo(a.x); v[1] = bfhi(a.x); v[2] = bflo(a.y); v[3] = bfhi(a.y); v[4] = bflo(a.z); v[5] = bfhi(a.z); v[6] = bflo(a.w); v[7] = bfhi(a.w);
    v[8] = bflo(b.x); v[9] = bfhi(b.x); v[10] = bflo(b.y); v[11] = bfhi(b.y); v[12] = bflo(b.z); v[13] = bfhi(b.z); v[14] = bflo(b.w); v[15] = bfhi(b.w);
}
__device__ __forceinline__ void k_assemble(const Params& p, int G, int c) {
    int tid = threadIdx.x; asm volatile("" : "+v"(tid));
    const int lane = tid & 63, wave = tid >> 6;
    const int gw = c * 8 + wave, NGW = G * 8;
    bf16_t* kn = (bf16_t*)(p.ws + WS_KN);
    const float* g = p.in[20] + (lane & 7) * 16;
    float gg[16];
#pragma unroll
    for (int i = 0; i < 16; ++i) gg[i] = g[i];
    for (int row0 = gw * 4; row0 < TALL; row0 += NGW * 4) {
        u32x4 a[4], b[4];
#pragma unroll
        for (int q = 0; q < 4; ++q) { const u32x4* ptr = (const u32x4*)(kn + (size_t)(row0 + q) * 1024 + lane * 16); a[q] = ptr[0]; b[q] = ptr[1]; }
#pragma unroll
        for (int q = 0; q < 4; ++q) {
            float v[16]; unpack16(a[q], b[q], v);
            float s = 0.f;
#pragma unroll
            for (int i = 0; i < 16; ++i) s += v[i] * v[i];
            s += __shfl_xor(s, 1); s += __shfl_xor(s, 2); s += __shfl_xor(s, 4);
            const float r = fast_rsqrt(s * (1.0f / 128.0f) + EPS);
            u32x4 oa, ob;
            oa.x = cvt_pk_bf16(v[0] * r * gg[0], v[1] * r * gg[1]); oa.y = cvt_pk_bf16(v[2] * r * gg[2], v[3] * r * gg[3]);
            oa.z = cvt_pk_bf16(v[4] * r * gg[4], v[5] * r * gg[5]); oa.w = cvt_pk_bf16(v[6] * r * gg[6], v[7] * r * gg[7]);
            ob.x = cvt_pk_bf16(v[8] * r * gg[8], v[9] * r * gg[9]); ob.y = cvt_pk_bf16(v[10] * r * gg[10], v[11] * r * gg[11]);
            ob.z = cvt_pk_bf16(v[12] * r * gg[12], v[13] * r * gg[13]); ob.w = cvt_pk_bf16(v[14] * r * gg[14], v[15] * r * gg[15]);
            u32x4* ptr = (u32x4*)(kn + (size_t)(row0 + q) * 1024 + lane * 16);
            ptr[0] = oa; ptr[1] = ob;
        }
    }
}

__device__ __forceinline__ void qlat_norm(const Params& p, int G, int c) {
    int tid = threadIdx.x; asm volatile("" : "+v"(tid));
    const int lane = tid & 63, wave = tid >> 6;
    const int gw = c * 8 + wave, NGW = G * 8;
    const float* raw = (const float*)(p.ws + WS_DQRAW); bf16_t* ql = (bf16_t*)(p.ws + WS_QLAT);
    for (int row0 = gw * 4; row0 < T; row0 += NGW * 4) {
        f32x2 v[4][3];
#pragma unroll
        for (int q = 0; q < 4; ++q)
#pragma unroll
            for (int j = 0; j < 3; ++j) v[q][j] = *(const f32x2*)(raw + (size_t)(row0 + q) * QL + 2 * lane + 128 * j);
#pragma unroll
        for (int q = 0; q < 4; ++q) {
            float s = 0.f;
#pragma unroll
            for (int j = 0; j < 3; ++j) s += v[q][j].x * v[q][j].x + v[q][j].y * v[q][j].y;
            s = wave_sum(s);
            const float r = fast_rsqrt(s * (1.0f / 384.0f) + EPS);
#pragma unroll
            for (int j = 0; j < 3; ++j) *(unsigned*)(ql + (size_t)(row0 + q) * QL + 2 * lane + 128 * j) = cvt_pk_bf16(v[q][j].x * r, v[q][j].y * r);
        }
    }
}

__device__ __forceinline__ void q_assemble(const Params& p, int i, int G, int c) {
    int tid = threadIdx.x; asm volatile("" : "+v"(tid));
    const int lane = tid & 63, wave = tid >> 6;
    const int gw = c * 8 + wave, NGW = G * 8;
    bf16_t* Q = (bf16_t*)(p.ws + WS_Q);
    const float* ct = (const float*)(p.ws + WS_ROPE); const float* st = ct + 2048 * 32;
    const int head = lane >> 3, sub = lane & 7;
    const float SC = 0.07216878364870323f * 1.4426950408889634f;
    float gn[16], gr[8];
#pragma unroll
    for (int j = 0; j < 16; ++j) gn[j] = p.in[25][i * 128 + sub * 16 + j] * SC;
#pragma unroll
    for (int j = 0; j < 8; ++j) gr[j] = p.in[26][i * 64 + sub * 8 + j];
    const int jb = (sub & 3) * 8;
    for (int row0 = gw * 2; row0 < T; row0 += NGW * 2) {
        u32x4 a[2], b[2], rw[2]; f32x4 c0[2], c1[2], n0[2], n1[2];
#pragma unroll
        for (int q = 0; q < 2; ++q) {
            const int row = row0 + q;
            const int pos = (row < TP) ? (row & (SEQ - 1)) : (PAST + ((row - TP) & 31));
            const bf16_t* qh = Q + (size_t)row * HQ + head * 192;
            const u32x4* pn = (const u32x4*)(qh + sub * 16); const u32x4* pr = (const u32x4*)(qh + 128 + sub * 8);
            a[q] = pn[0]; b[q] = pn[1]; rw[q] = pr[0];
            c0[q] = *(const f32x4*)(ct + pos * 32 + jb); c1[q] = *(const f32x4*)(ct + pos * 32 + jb + 4);
            n0[q] = *(const f32x4*)(st + pos * 32 + jb); n1[q] = *(const f32x4*)(st + pos * 32 + jb + 4);
        }
#pragma unroll
        for (int q = 0; q < 2; ++q) {
            const int row = row0 + q;
            bf16_t* qh = Q + (size_t)row * HQ + head * 192;
            u32x4* pn = (u32x4*)(qh + sub * 16); u32x4* pr = (u32x4*)(qh + 128 + sub * 8);
            float v[16], rv[8];
            unpack16(a[q], b[q], v);
            rv[0] = bflo(rw[q].x); rv[1] = bfhi(rw[q].x); rv[2] = bflo(rw[q].y); rv[3] = bfhi(rw[q].y); rv[4] = bflo(rw[q].z); rv[5] = bfhi(rw[q].z); rv[6] = bflo(rw[q].w); rv[7] = bfhi(rw[q].w);
            float s = 0.f, s2 = 0.f;
#pragma unroll
            for (int j = 0; j < 16; ++j) s += v[j] * v[j];
#pragma unroll
            for (int j = 0; j < 8; ++j) s2 += rv[j] * rv[j];
            s += __shfl_xor(s, 1); s += __shfl_xor(s, 2); s += __shfl_xor(s, 4);
            s2 += __shfl_xor(s2, 1); s2 += __shfl_xor(s2, 2); s2 += __shfl_xor(s2, 4);
            const float rn = fast_rsqrt(s * (1.0f / 128.0f) + EPS), rr = fast_rsqrt(s2 * (1.0f / 64.0f) + EPS);
            u32x4 oa, ob;
            oa.x = cvt_pk_bf16(v[0] * rn * gn[0], v[1] * rn * gn[1]); oa.y = cvt_pk_bf16(v[2] * rn * gn[2], v[3] * rn * gn[3]);
            oa.z = cvt_pk_bf16(v[4] * rn * gn[4], v[5] * rn * gn[5]); oa.w = cvt_pk_bf16(v[6] * rn * gn[6], v[7] * rn * gn[7]);
            ob.x = cvt_pk_bf16(v[8] * rn * gn[8], v[9] * rn * gn[9]); ob.y = cvt_pk_bf16(v[10] * rn * gn[10], v[11] * rn * gn[11]);
            ob.z = cvt_pk_bf16(v[12] * rn * gn[12], v[13] * rn * gn[13]); ob.w = cvt_pk_bf16(v[14] * rn * gn[14], v[15] * rn * gn[15]);
            pn[0] = oa; pn[1] = ob;
            float o[8];
#pragma unroll
            for (int j = 0; j < 8; ++j) {
                const float me = rv[j] * rr * gr[j];
                const float other = __shfl_xor(me, 4);
                const float cs = (j < 4) ? c0[q][j & 3] : c1[q][j & 3], sn = (j < 4) ? n0[q][j & 3] : n1[q][j & 3];
                o[j] = ((sub < 4) ? (me * cs - other * sn) : (me * cs + other * sn)) * SC;
            }
            u32x4 orr; orr.x = cvt_pk_bf16(o[0], o[1]); orr.y = cvt_pk_bf16(o[2], o[3]); orr.z = cvt_pk_bf16(o[4], o[5]); orr.w = cvt_pk_bf16(o[6], o[7]);
            pr[0] = orr;
        }
    }
}

#define MFMA32(a, b, c) __builtin_amdgcn_mfma_f32_32x32x16_bf16((a), (b), (c), 0, 0, 0)
constexpr int KSTR = 400, VSTR = 144, KBUF = 64 * KSTR, VBUF = 128 * VSTR, ABUF = KBUF + VBUF;
__device__ __forceinline__ void attn_phase(const Params& p, LAS unsigned char* lds, int G, int c) {
    int tid = threadIdx.x; asm volatile("" : "+v"(tid));
    const int wid = __builtin_amdgcn_readfirstlane(tid >> 6), lane = tid & 63, l32 = lane & 31, hi = lane >> 5;
    const bf16_t* Q = (const bf16_t*)(p.ws + WS_Q); const bf16_t* KN = (const bf16_t*)(p.ws + WS_KN); const bf16_t* KR = (const bf16_t*)(p.ws + WS_KR);
    const bf16_t* VT = (const bf16_t*)(p.ws + WS_VT); bf16_t* O = (bf16_t*)(p.ws + WS_O);
    for (int idx = c; idx < 2048 + 64; idx += G) {
        int h, qrow0, krow0, ntiles, wave_last; bool partial;
        if (idx < 2048) { const int bh = idx & 255, r = idx >> 8, qblk = (r & 1) ? (r >> 1) : 7 - (r >> 1), b = bh >> 3; h = bh & 7;
            qrow0 = b * SEQ + qblk * 256; krow0 = b * SEQ; ntiles = 4 * qblk + 4; wave_last = 4 * qblk + (wid >> 1); partial = false; }
        else { const int s = idx - 2048, b = s >> 3; h = s & 7; qrow0 = TP + b * DSEQ; krow0 = TP + b * SKEY; ntiles = 17; wave_last = (wid == 0) ? 16 : -1; partial = true; }
        const bool active = wave_last >= 0;
        bf16x8 qf[12];
        if (active) {
            const bf16_t* qp = Q + (size_t)(qrow0 + wid * 32 + l32) * HQ + h * 192 + hi * 8;
#pragma unroll
            for (int kk = 0; kk < 12; ++kk) qf[kk] = *(const bf16x8*)(qp + kk * 16);
        } else {
#pragma unroll
            for (int kk = 0; kk < 12; ++kk) qf[kk] = (bf16x8){0, 0, 0, 0, 0, 0, 0, 0};
        }
        f32x16 o[4];
#pragma unroll
        for (int d = 0; d < 4; ++d)
#pragma unroll
            for (int r = 0; r < 16; ++r) o[d][r] = 0.f;
        float mrun = -INFINITY, lsum = 0.f;
        const int kp0 = tid, kp1 = tid + 512;
        const int rk = tid >> 3, rc = tid & 7;
        const int vp0 = tid, vp1 = tid + 512;
        const bf16_t* gk0 = KN + (size_t)(krow0 + (kp0 >> 4)) * 1024 + h * 128 + (kp0 & 15) * 8;
        const bf16_t* gk1 = KN + (size_t)(krow0 + (kp1 >> 4)) * 1024 + h * 128 + (kp1 & 15) * 8;
        const bf16_t* gr = KR + (size_t)(krow0 + rk) * 64 + rc * 8;
        const bf16_t* gv0 = VT + (size_t)(h * 128 + (vp0 >> 3)) * TALL + krow0 + (vp0 & 7) * 8;
        const bf16_t* gv1 = VT + (size_t)(h * 128 + (vp1 >> 3)) * TALL + krow0 + (vp1 & 7) * 8;
        const int lk0 = (kp0 >> 4) * KSTR + (kp0 & 15) * 16, lk1 = (kp1 >> 4) * KSTR + (kp1 & 15) * 16, lr = rk * KSTR + 256 + rc * 16;
        const int lv0 = KBUF + (vp0 >> 3) * VSTR + ((vp0 & 7) >> 1) * 32 + 8 * (vp0 & 1);
        const int lv1 = KBUF + (vp1 >> 3) * VSTR + ((vp1 & 7) >> 1) * 32 + 8 * (vp1 & 1);
        u32x4 sk0, sk1, sr, sv0, sv1;
#define ATT_LOAD(t) do { sk0 = *(const u32x4*)(gk0 + (size_t)(t) * 64 * 1024); sk1 = *(const u32x4*)(gk1 + (size_t)(t) * 64 * 1024); sr = *(const u32x4*)(gr + (size_t)(t) * 64 * 64); \
                         sv0 = *(const u32x4*)(gv0 + (t) * 64); sv1 = *(const u32x4*)(gv1 + (t) * 64); } while (0)
#define ATT_WRITE(bufp) do { LAS unsigned char* _b = (bufp); *(LAS u32x4*)(_b + lk0) = sk0; *(LAS u32x4*)(_b + lk1) = sk1; *(LAS u32x4*)(_b + lr) = sr; \
                         *(LAS u32x2*)(_b + lv0) = (u32x2){sv0.x, sv0.y}; *(LAS u32x2*)(_b + lv0 + 16) = (u32x2){sv0.z, sv0.w}; \
                         *(LAS u32x2*)(_b + lv1) = (u32x2){sv1.x, sv1.y}; *(LAS u32x2*)(_b + lv1 + 16) = (u32x2){sv1.z, sv1.w}; } while (0)
        ATT_LOAD(0);
        ATT_WRITE(lds);
        __syncthreads();
        for (int t = 0; t < ntiles; ++t) {
            LAS unsigned char* buf = lds + (t & 1) * ABUF;
            if (t + 1 < ntiles) ATT_LOAD(t + 1);
            if (t <= wave_last) {
                f32x16 s0, s1;
#pragma unroll
                for (int r = 0; r < 16; ++r) { s0[r] = 0.f; s1[r] = 0.f; }
                const LAS unsigned char* kb = buf + l32 * KSTR + hi * 16;
#pragma unroll
                for (int kk = 0; kk < 12; ++kk) {
                    const bf16x8 a0 = *(const LAS bf16x8*)(kb + kk * 32);
                    const bf16x8 a1 = *(const LAS bf16x8*)(kb + 32 * KSTR + kk * 32);
                    s0 = MFMA32(a0, qf[kk], s0);
                    s1 = MFMA32(a1, qf[kk], s1);
                }
                if (partial && t == ntiles - 1) {
#pragma unroll
                    for (int r = 0; r < 16; ++r) s1[r] = -INFINITY;
                }
                float mx = s0[0];
#pragma unroll
                for (int r = 1; r < 16; ++r) mx = fmaxf(mx, s0[r]);
#pragma unroll
                for (int r = 0; r < 16; ++r) mx = fmaxf(mx, s1[r]);
                mx = fmaxf(mx, __shfl_xor(mx, 32));
                const float mnew = fmaxf(mrun, mx);
                const float alpha = __builtin_amdgcn_exp2f(mrun - mnew);
                mrun = mnew;
                float rs = 0.f;
#pragma unroll
                for (int r = 0; r < 16; ++r) { s0[r] = __builtin_amdgcn_exp2f(s0[r] - mnew); s1[r] = __builtin_amdgcn_exp2f(s1[r] - mnew); rs += s0[r] + s1[r]; }
                lsum = lsum * alpha + rs;
#pragma unroll
                for (int d = 0; d < 4; ++d)
#pragma unroll
                    for (int r = 0; r < 16; ++r) o[d][r] *= alpha;
                bf16x8 pf[4];
                {
                    u32x4 w;
                    w.x = cvt_pk_bf16(s0[0], s0[1]); w.y = cvt_pk_bf16(s0[2], s0[3]); w.z = cvt_pk_bf16(s0[4], s0[5]); w.w = cvt_pk_bf16(s0[6], s0[7]); pf[0] = __builtin_bit_cast(bf16x8, w);
                    w.x = cvt_pk_bf16(s0[8], s0[9]); w.y = cvt_pk_bf16(s0[10], s0[11]); w.z = cvt_pk_bf16(s0[12], s0[13]); w.w = cvt_pk_bf16(s0[14], s0[15]); pf[1] = __builtin_bit_cast(bf16x8, w);
                    w.x = cvt_pk_bf16(s1[0], s1[1]); w.y = cvt_pk_bf16(s1[2], s1[3]); w.z = cvt_pk_bf16(s1[4], s1[5]); w.w = cvt_pk_bf16(s1[6], s1[7]); pf[2] = __builtin_bit_cast(bf16x8, w);
                    w.x = cvt_pk_bf16(s1[8], s1[9]); w.y = cvt_pk_bf16(s1[10], s1[11]); w.z = cvt_pk_bf16(s1[12], s1[13]); w.w = cvt_pk_bf16(s1[14], s1[15]); pf[3] = __builtin_bit_cast(bf16x8, w);
                }
                const LAS unsigned char* vb = buf + KBUF + l32 * VSTR + hi * 16;
#pragma unroll
                for (int d = 0; d < 4; ++d)
#pragma unroll
                    for (int ks = 0; ks < 4; ++ks) {
                        const bf16x8 vf = *(const LAS bf16x8*)(vb + d * 32 * VSTR + ks * 32);
                        o[d] = MFMA32(vf, pf[ks], o[d]);
                    }
            }
            if (t + 1 < ntiles) ATT_WRITE(lds + ((t + 1) & 1) * ABUF);
            __syncthreads();
        }
        if (active) {
            const float l = lsum + __shfl_xor(lsum, 32);
            const float inv = 1.0f / l;
            bf16_t* op = O + (size_t)(qrow0 + wid * 32 + l32) * DM + h * 128 + 4 * hi;
#pragma unroll
            for (int d = 0; d < 4; ++d)
#pragma unroll
                for (int g4 = 0; g4 < 4; ++g4) {
                    u32x2 w; w.x = cvt_pk_bf16(o[d][4 * g4] * inv, o[d][4 * g4 + 1] * inv); w.y = cvt_pk_bf16(o[d][4 * g4 + 2] * inv, o[d][4 * g4 + 3] * inv);
                    *(u32x2*)(op + d * 32 + 8 * g4) = w;
                }
        }
#undef ATT_LOAD
#undef ATT_WRITE
    }
}

#define XB_TMO      128
#define XB_XCNT(j)  (256  + 64 * (j))
#define XB_XSUB(j)  (1280 + 64 * (j))
#define XB_XGEN(j)  (2304 + 64 * (j))
#define XB_TOP      3328
#define XB_TOPGEN   3392
#define XCD_BAR_WORDS 3456
#define XB_SPIN_CAP (1u << 18)
__device__ __forceinline__ unsigned xb_ld(unsigned* p)              { return __hip_atomic_load(p, __ATOMIC_RELAXED, __HIP_MEMORY_SCOPE_AGENT); }
__device__ __forceinline__ unsigned xb_add(unsigned* p, unsigned v) { return __hip_atomic_fetch_add(p, v, __ATOMIC_RELAXED, __HIP_MEMORY_SCOPE_AGENT); }
__device__ __forceinline__ unsigned xb_xcc_id() { return (unsigned)__builtin_amdgcn_s_getreg((3 << 11) | 20) & 0xFu; }
#define XB_SPIN(cond, bar) do { unsigned _sp = 0; while (cond) { __builtin_amdgcn_s_sleep(1); \
    if ((++_sp & 255u) == 0u) { if (xb_ld(&(bar)[XB_TMO])) break; if (_sp > XB_SPIN_CAP) { atomicAdd(&(bar)[XB_TMO], 1u); break; } } } } while (0)
struct XcdBarrier { unsigned* bar; unsigned x; volatile LAS unsigned* st; };
__device__ __forceinline__ XcdBarrier xcd_barrier_post(unsigned* bar, volatile LAS unsigned* st) {
    XcdBarrier b; b.bar = bar; b.x = xb_xcc_id(); b.st = st;
    if (threadIdx.x == 0) (void)xb_add(&bar[XB_XCNT(b.x)], 1u);
    return b;
}
__device__ __forceinline__ void xcd_barrier_complete(unsigned* bar, unsigned x, unsigned& nloc, unsigned& nx) {
    const unsigned G = gridDim.x * gridDim.y * gridDim.z;
    unsigned sum, cnt, mine, sp = 0u;
    for (;;) {
        sum = 0u; cnt = 0u; mine = 0u;
#pragma unroll
        for (unsigned j = 0; j < 16; ++j) { const unsigned c = xb_ld(&bar[XB_XCNT(j)]); sum += c; cnt += (c > 0u) ? 1u : 0u; mine = (j == x) ? c : mine; }
        if (sum == G) break;
        __builtin_amdgcn_s_sleep(1);
        if ((++sp & 255u) == 0u) { if (xb_ld(&bar[XB_TMO])) break; if (sp > XB_SPIN_CAP) { atomicAdd(&bar[XB_TMO], 1u); break; } }
    }
    nloc = mine > 0u ? mine : 1u; nx = cnt > 0u ? cnt : 1u;
}
__device__ __forceinline__ void xcd_barrier(const XcdBarrier& b) {
    asm volatile("s_waitcnt vmcnt(0)" ::: "memory");
    __syncthreads();
    if (threadIdx.x == 0) {
        unsigned* bar = b.bar;
        __builtin_amdgcn_s_waitcnt(0);
        unsigned nloc = b.st[0], nx = b.st[1];
        if (nloc == 0u) { xcd_barrier_complete(bar, b.x, nloc, nx); b.st[0] = nloc; b.st[1] = nx; }
        const unsigned old = xb_add(&bar[XB_XSUB(b.x)], 1u);
        const unsigned gen = old / nloc;
        if (old + 1u == (gen + 1u) * nloc) {
            __builtin_amdgcn_fence(__ATOMIC_RELEASE, "agent");
            asm volatile("s_waitcnt vmcnt(0)" ::: "memory");
            const unsigned og = xb_add(&bar[XB_TOP], 1u);
            const unsigned tg = og / nx;
            if (og + 1u == (tg + 1u) * nx) xb_add(&bar[XB_TOPGEN], 1u);
            else XB_SPIN(xb_ld(&bar[XB_TOPGEN]) == tg, bar);
            __builtin_amdgcn_fence(__ATOMIC_ACQUIRE, "agent");
            xb_add(&bar[XB_XGEN(b.x)], 1u);
            asm volatile("s_waitcnt vmcnt(0)" ::: "memory");
        } else {
            XB_SPIN(xb_ld(&bar[XB_XGEN(b.x)]) == gen, bar);
            __builtin_amdgcn_fence(__ATOMIC_ACQUIRE, "agent");
            asm volatile("s_waitcnt vmcnt(0)" ::: "memory");
        }
    }
    __syncthreads();
}

__global__ void __launch_bounds__(NTHREADS, 2) yoco_fwd(Params p) {
    extern __shared__ __attribute__((aligned(16))) unsigned char lds_raw[];
    LAS unsigned char* lds = (LAS unsigned char*)lds_raw;
    cg::grid_group grid = cg::this_grid();
    const int G = gridDim.x, c = blockIdx.x;
    unsigned char* ws = p.ws;
    bf16_t* xb = (bf16_t*)(ws + WS_XB); bf16_t* Hb = (bf16_t*)(ws + WS_H);
    float* ssqb = (float*)(ws + WS_SSQ);
    float* xo = p.out;
    int cur = 0;
    volatile LAS unsigned* bst = (volatile LAS unsigned*)(lds + 131072);
    if (threadIdx.x < 4) bst[threadIdx.x] = 0u;
    __syncthreads();
    XcdBarrier xbar = xcd_barrier_post((unsigned*)(ws + WS_BAR), bst);

    for (int rep = 0; rep < DUP_P0; ++rep) { phase0(p, lds, G, c); if (rep + 1 < DUP_P0) __syncthreads(); }
    grid.sync();
#define GRID_BAR() xcd_barrier(xbar)

    for (int l = 0; l < 4; ++l) {
        for (int hf = 0; hf < 2; ++hf) {
            if (hf == 1) {
                if (l < 2) {
#ifndef NO_PP
                    pool_prep(p, l, ssqb + (size_t)cur * 16 * T, lds, G, c);
#endif
                    GRID_BAR();
                    {
                        pg8::Gemm g{(const bf16_t*)(ws + WS_D), (const bf16_t*)(ws + WS_WPOOL) + (size_t)l * 1024 * 256, 256, 256, 256, T / 256, 4, (size_t)T * 256 * 2};
                        pg8::StaticOrder S; S.init(T / 256, 4, G, c);
                        pg8::EpiResid E{xo, xo + (size_t)TP * DM, xo, xb, ssqb + (size_t)(cur ^ 1) * 16 * T, p.in[13] + l * DM, 1.0f};
#ifndef NO_EPIRESID
                        pg8::gemm_phase<pg8::EpiResid>(lds, g, S, E);
#endif
                    }
                    cur ^= 1;
                    GRID_BAR();
                } else {
                    const int i = l - 2;
                    {
                        pg8::Gemm g{xb, (const bf16_t*)(ws + WS_WDQ) + (size_t)i * 512 * 1024, 1024, 1024, 1024, T / 256, 2, 0};
                        pg8::StaticOrder S; S.init(T / 256, 2, G, c);
                        pg8::EpiRawF32 E{(float*)(ws + WS_DQRAW), QL, QL, ssqb + (size_t)cur * 16 * T};
#ifndef NO_EPIRAWF32
                        pg8::gemm_phase<pg8::EpiRawF32>(lds, g, S, E);
#endif
                    }
                    GRID_BAR();
#ifndef NO_EW
                    qlat_norm(p, G, c);
#endif
                    GRID_BAR();
                    {
                        pg8::Gemm g{(const bf16_t*)(ws + WS_QLAT), (const bf16_t*)(ws + WS_WUQ) + (size_t)i * 1536 * 384, 384, 384, 384, T / 256, 6, 0};
                        pg8::StaticOrder S; S.init(T / 256, 6, G, c);
                        pg8::EpiRawBf16 E{(bf16_t*)(ws + WS_Q), HQ};
#ifndef NO_EPIRAWBF16
                        pg8::gemm_phase<pg8::EpiRawBf16>(lds, g, S, E);
#endif
                    }
                    GRID_BAR();
#ifndef NO_QA
                    q_assemble(p, i, G, c);
#endif
                    GRID_BAR();
                    for (int rep = 0; rep < DUP_ATT; ++rep) attn_phase(p, lds, G, c);
                    GRID_BAR();
                    {
                        pg8::Gemm g{(const bf16_t*)(ws + WS_O), (const bf16_t*)(ws + WS_WO) + (size_t)i * 1024 * 1024, 1024, 1024, 1024, T / 256, 4, 0};
                        pg8::StaticOrder S; S.init(T / 256, 4, G, c);
                        pg8::EpiResid E{xo, xo + (size_t)TP * DM, xo, xb, ssqb + (size_t)(cur ^ 1) * 16 * T, nullptr, 1.0f};
#ifndef NO_EPIRESID
                        pg8::gemm_phase<pg8::EpiResid>(lds, g, S, E);
#endif
                    }
                    cur ^= 1;
                    GRID_BAR();
                }
            }
            {
                pg8::Gemm g{xb, (const bf16_t*)(ws + WS_WIN + (size_t)(2 * l + hf) * SZ_WIN), 1024, 1024, 1024, T / 256, 22, 0};
                pg8::StaticOrder S; S.init(T / 256, 22, G, c);
                pg8::EpiSwiglu E{Hb, ssqb + (size_t)cur * 16 * T};
                for (int rep = 0; rep < DUP_FFNIN; ++rep) pg8::gemm_phase<pg8::EpiSwiglu>(lds, g, S, E);
            }
            GRID_BAR();
            {
                pg8::Gemm g{Hb, (const bf16_t*)(ws + WS_WOUT + (size_t)(2 * l + hf) * SZ_WOUT), FF, FF, FF, T / 256, 4, 0};
                pg8::StaticOrder S; S.init(T / 256, 4, G, c);
                const bool first = (l == 0 && hf == 0);
                pg8::EpiResid E{first ? p.in[0] : xo, first ? p.in[1] : xo + (size_t)TP * DM, xo, xb, ssqb + (size_t)(cur ^ 1) * 16 * T, nullptr, 0.5f};
#ifndef NO_EPIRESID
                pg8::gemm_phase<pg8::EpiResid>(lds, g, S, E);
#endif
            }
            cur ^= 1;
            GRID_BAR();
        }
        if (l == 1) {
            {
                pg8::Gemm g{xb, (const bf16_t*)(ws + WS_WDKV), 1024, 1024, 1024, T / 256, 2, 0};
                pg8::StaticOrder S; S.init(T / 256, 2, G, c);
                pg8::EpiRawF32 E{(float*)(ws + WS_LATRAW), LATW, LATW, ssqb + (size_t)cur * 16 * T};
#ifndef NO_EPIRAWF32
                pg8::gemm_phase<pg8::EpiRawF32>(lds, g, S, E);
#endif
            }
            GRID_BAR();
#ifndef NO_EW
            latent_norm(p, G, c);
#endif
            GRID_BAR();
            {
                pg8::Gemm g{(const bf16_t*)(ws + WS_CALL), (const bf16_t*)(ws + WS_WUK), 256, 256, 256, TALL / 256, 4, 0};
                pg8::StaticOrder S; S.init(TALL / 256, 4, G, c);
                pg8::EpiRawBf16 E{(bf16_t*)(ws + WS_KN), 1024};
#ifndef NO_EPIRAWBF16
                pg8::gemm_phase<pg8::EpiRawBf16>(lds, g, S, E);
#endif
            }
            {
                pg8::Gemm g{(const bf16_t*)(ws + WS_WUV), (const bf16_t*)(ws + WS_CALL), 256, 256, 256, 4, TALL / 256, 0};
                pg8::StaticOrder S; S.init(4, TALL / 256, G, c);
                pg8::EpiRawBf16 E{(bf16_t*)(ws + WS_VT), TALL};
#ifndef NO_EPIRAWBF16
                pg8::gemm_phase<pg8::EpiRawBf16>(lds, g, S, E);
#endif
            }
            GRID_BAR();
#ifndef NO_KA
            k_assemble(p, G, c);
#endif
            GRID_BAR();
        }
    }
}

extern "C" void kernel_launch(void* const* d_in, const int* in_sizes, int n_in, void* d_out, int out_size, void* d_ws, size_t ws_size, hipStream_t stream) {
    static int grid_blocks = 0;
    if (grid_blocks == 0) {
        if (n_in != 28 || ws_size < WS_END) { fprintf(stderr, "kernel_launch: unexpected n_in %d or ws_size %zu (need %zu)\n", n_in, ws_size, (size_t)WS_END); }
        int dev = 0, cus = 0, per_cu = 0;
        hipGetDevice(&dev);
        hipDeviceGetAttribute(&cus, hipDeviceAttributeMultiprocessorCount, dev);
        if (hipFuncSetAttribute((const void*)yoco_fwd, hipFuncAttributeMaxDynamicSharedMemorySize, LDS_BYTES) != hipSuccess) fprintf(stderr, "kernel_launch: hipFuncSetAttribute failed\n");
        if (hipOccupancyMaxActiveBlocksPerMultiprocessor(&per_cu, (const void*)yoco_fwd, NTHREADS, LDS_BYTES) != hipSuccess || per_cu < 1) { fprintf(stderr, "kernel_launch: occupancy query gave %d\n", per_cu); per_cu = 1; }
        (void)hipGetLastError();
        grid_blocks = cus * 1;
        if (grid_blocks <= 0) grid_blocks = 256;
    }
    if (hipMemsetAsync((char*)d_ws + WS_BAR, 0, 16384, stream) != hipSuccess) fprintf(stderr, "kernel_launch: memset of barrier words failed\n");
    Params p{};
    for (int i = 0; i < 28; ++i) p.in[i] = (const float*)d_in[i];
    p.out = (float*)d_out; p.ws = (unsigned char*)d_ws;
    void* args[] = {&p};
    hipError_t e = hipLaunchCooperativeKernel((const void*)yoco_fwd, dim3(grid_blocks), dim3(NTHREADS), args, LDS_BYTES, stream);
    if (e != hipSuccess) fprintf(stderr, "cooperative launch failed: %s (grid %d)\n", hipGetErrorString(e), grid_blocks);
}
```

```cpp
#include <hip/hip_runtime.h>
#include <hip/hip_cooperative_groups.h>
#include <cstdio>
#include <cstdint>
namespace cg = cooperative_groups;

#define LAS __attribute__((address_space(3)))
#ifndef DUP_FFNIN
#define DUP_FFNIN 1
#endif
#ifndef DUP_ATT
#define DUP_ATT 1
#endif
#ifndef DUP_SYNC
#define DUP_SYNC 1
#endif
#ifndef DUP_P0
#define DUP_P0 1
#endif
typedef unsigned short bf16_t;
typedef short bf16x8 __attribute__((ext_vector_type(8)));
typedef float f32x4 __attribute__((ext_vector_type(4)));
typedef float f32x2 __attribute__((ext_vector_type(2)));
typedef float f32x16 __attribute__((ext_vector_type(16)));
typedef unsigned u32x4 __attribute__((ext_vector_type(4)));
typedef unsigned u32x2 __attribute__((ext_vector_type(2)));

constexpr int DM = 1024, FF = 2816, TP = 65536, TS = 256, T = TP + TS, SEQ = 2048, NBATCH = 32, DBATCH = 8, DSEQ = 32, PAST = 1024;
constexpr int SKEY = 1088;
constexpr int TALL = TP + DBATCH * SKEY;
constexpr int KVL = 256, QL = 384, HQ = 1536, NH = 8, LATW = 320;
constexpr float EPS = 1e-6f;
constexpr int NTHREADS = 512;
constexpr int LDS_BYTES = 131072 + 1024;

constexpr size_t OUT_Y = 0;
constexpr size_t OUT_POOL_P = (size_t)T * DM;
constexpr size_t OUT_POOL_S = OUT_POOL_P + (size_t)2 * 32 * 15 * 1024;
constexpr size_t OUT_CKV_P = OUT_POOL_S + (size_t)2 * 8 * 15 * 1024;
constexpr size_t OUT_KR_P = OUT_CKV_P + (size_t)TP * 256;
constexpr size_t OUT_CKV_S = OUT_KR_P + (size_t)TP * 64;
constexpr size_t OUT_KR_S = OUT_CKV_S + (size_t)TS * 256;

constexpr size_t SZ_WIN = (size_t)5632 * 1024 * 2, SZ_WOUT = (size_t)1024 * 2816 * 2;
constexpr size_t WS_WIN = 0;
constexpr size_t WS_WOUT = WS_WIN + 8 * SZ_WIN;
constexpr size_t WS_WPOOL = WS_WOUT + 8 * SZ_WOUT;
constexpr size_t WS_WDKV = WS_WPOOL + (size_t)2 * 1024 * 256 * 2;
constexpr size_t WS_WUK = WS_WDKV + (size_t)512 * 1024 * 2;
constexpr size_t WS_WUV = WS_WUK + (size_t)1024 * 256 * 2;
constexpr size_t WS_WDQ = WS_WUV + (size_t)1024 * 256 * 2;
constexpr size_t WS_WUQ = WS_WDQ + (size_t)2 * 512 * 1024 * 2;
constexpr size_t WS_WO = WS_WUQ + (size_t)2 * 1536 * 384 * 2;
constexpr size_t WS_XB = WS_WO + (size_t)2 * 1024 * 1024 * 2;
constexpr size_t WS_H = WS_XB + (size_t)T * 1024 * 2;
constexpr size_t SZ_H = (size_t)T * FF * 2;
constexpr size_t WS_D = WS_H;
constexpr size_t WS_LATRAW = WS_H;
constexpr size_t WS_CALL = WS_H + (size_t)T * LATW * 4;
constexpr size_t WS_Q = WS_H;
constexpr size_t WS_O = WS_H + (size_t)T * HQ * 2;
constexpr size_t WS_DQRAW = WS_O;
constexpr size_t WS_KN = WS_H + SZ_H;
constexpr size_t WS_VT = WS_KN + (size_t)TALL * 1024 * 2;
constexpr size_t WS_KR = WS_VT + (size_t)TALL * 1024 * 2;
constexpr size_t WS_QLAT = WS_KR + (size_t)TALL * 64 * 2;
constexpr size_t WS_SSQ = WS_QLAT + (size_t)T * QL * 2;
constexpr size_t WS_ROPE = WS_SSQ + (size_t)2 * 16 * T * 4;
constexpr size_t WS_BAR = WS_ROPE + (size_t)2 * 2048 * 32 * 4;
constexpr size_t WS_END = WS_BAR + 16384;
static_assert(WS_O + (size_t)T * 1024 * 2 <= WS_H + SZ_H, "Q+O overlay");
static_assert(WS_CALL + (size_t)TALL * 256 * 2 <= WS_H + SZ_H, "latent overlay");
static_assert(WS_END <= (size_t)1 << 30, "workspace");

struct Params {
    const float* in[28];
    float* out;
    unsigned char* ws;
};

typedef __bf16 bf16x2_t __attribute__((ext_vector_type(2)));
__device__ __forceinline__ unsigned cvt_pk_bf16(float lo, float hi) { const f32x2 v = {lo, hi}; const bf16x2_t r = __builtin_convertvector(v, bf16x2_t); return __builtin_bit_cast(unsigned, r); }
__device__ __forceinline__ float bf2f(unsigned short b) { return __uint_as_float(((unsigned)b) << 16); }
__device__ __forceinline__ float bflo(unsigned w) { return __uint_as_float(w << 16); }
__device__ __forceinline__ float bfhi(unsigned w) { return __uint_as_float(w & 0xffff0000u); }
__device__ __forceinline__ float fast_rsqrt(float x) { return 1.0f / sqrtf(x); }
__device__ __forceinline__ float silu_mul(float g, float u) { return g * __builtin_amdgcn_rcpf(1.0f + __builtin_amdgcn_exp2f(-1.4426950408889634f * g)) * u; }

namespace pg8 {
constexpr int BM = 256, BK = 64, HALF = 128, HTB = HALF * BK * 2, STAGE_BYTES = 8 * HTB, NXCD = 8, WGM = 8;
__device__ __forceinline__ int lds_byte(int r, int c) { const int st = (r >> 4) * 2 + (c >> 5), rr = r & 15, cc = c & 31, ob = rr * 64 + cc * 2; return st * 1024 + (ob ^ (((ob >> 9) & 1) << 5)); }
__device__ __forceinline__ void stage_rc(int b, int& R, int& C) { const int st = b / 1024, sb = b % 1024, swz = sb ^ (((sb >> 9) & 1) << 5); R = (st >> 1) * 16 + swz / 64; C = (st & 1) * 32 + (swz % 64) / 2; }
__device__ __forceinline__ int perm32(int rho) { const int n = rho >> 4, i = rho & 15; return 8 * (i >> 2) + 4 * n + (i & 3); }

struct Unit { int pm, pn; };
struct Gemm { const bf16_t* A; const bf16_t* Bt; int lda, ldb, K, nM, nN; size_t a_pn_stride; };

struct StaticOrder {
    int nM, nN, nwg, G, c;
    __device__ void init(int nM_, int nN_, int G_, int c_) { nM = nM_; nN = nN_; nwg = nM * nN; G = G_; c = c_; }
    __device__ bool next(int i, Unit& u) const {
        const long L = (long)i * G + c; if (L >= nwg) return false;
        int wgid = (int)L; { const int q = nwg / NXCD, r = nwg % NXCD, xcd = wgid % NXCD, off = wgid / NXCD; wgid = (xcd < r ? xcd * (q + 1) : r * (q + 1) + (xcd - r) * q) + off; }
        const int nig = WGM * nN, gid = wgid / nig, fm = gid * WGM, gsz = (nM - fm) < WGM ? (nM - fm) : WGM;
        u.pm = fm + ((wgid % nig) % gsz); u.pn = (wgid % nig) / gsz; return true;
    }
};


__device__ __forceinline__ float row_rstd(const float* ssq, int row, int fq) {
    float s = 0.f;
#pragma unroll
    for (int j = 0; j < 4; ++j) s += ssq[(size_t)(4 * fq + j) * T + row];
    s += __shfl_xor(s, 16); s += __shfl_xor(s, 32);
    return fast_rsqrt(s * (1.0f / 1024.0f) + EPS);
}

struct EpiSwiglu {
    static constexpr bool PERM = true;
    bf16_t* H; const float* ssq;
    __device__ __forceinline__ void operator()(const f32x4 (&acc)[2][2][4][2], const Unit& u, int wr, int wc, int fr_, int fq_) const {
        int fr = fr_, fq = fq_; asm volatile("" : "+v"(fr), "+v"(fq));
        const int row0 = u.pm * BM + wr * 64 + fr;
#pragma unroll
        for (int ai = 0; ai < 2; ++ai)
#pragma unroll
            for (int m = 0; m < 4; ++m) {
                const int row = row0 + ai * HALF + m * 16;
                const float r = row_rstd(ssq, row, fq);
                const f32x4 g0 = acc[ai][0][m][0] * r, g1 = acc[ai][0][m][1] * r, u0 = acc[ai][1][m][0] * r, u1 = acc[ai][1][m][1] * r;
                u32x4 w;
                w.x = cvt_pk_bf16(silu_mul(g0[0], u0[0]), silu_mul(g0[1], u0[1]));
                w.y = cvt_pk_bf16(silu_mul(g0[2], u0[2]), silu_mul(g0[3], u0[3]));
                w.z = cvt_pk_bf16(silu_mul(g1[0], u1[0]), silu_mul(g1[1], u1[1]));
                w.w = cvt_pk_bf16(silu_mul(g1[2], u1[2]), silu_mul(g1[3], u1[3]));
                *(u32x4*)(H + (size_t)row * FF + u.pn * 128 + wc * 32 + 8 * fq) = w;
            }
    }
};

struct EpiResid {
    static constexpr bool PERM = false;
    const float* res0; const float* res1; float* out; bf16_t* xb; float* ssq; const float* colscale; float cs;
    __device__ __forceinline__ void operator()(const f32x4 (&acc)[2][2][4][2], const Unit& u, int wr, int wc, int fr_, int fq_) const {
        int fr = fr_, fq = fq_; asm volatile("" : "+v"(fr), "+v"(fq));
        const int row0 = u.pm * BM + wr * 64 + fr;
#pragma unroll
        for (int ai = 0; ai < 2; ++ai)
#pragma unroll
            for (int m = 0; m < 4; ++m) {
                const int row = row0 + ai * HALF + m * 16;
                const float* rp = (row < TP) ? res0 + (size_t)row * DM : res1 + (size_t)(row - TP) * DM;
                float sq = 0.f;
#pragma unroll
                for (int bj = 0; bj < 2; ++bj)
#pragma unroll
                    for (int n = 0; n < 2; ++n) {
                        const int col = u.pn * BM + bj * HALF + wc * 32 + n * 16 + 4 * fq;
                        const f32x4 rv = *(const f32x4*)(rp + col);
                        f32x4 sc = (f32x4){cs, cs, cs, cs};
                        if (colscale) sc = *(const f32x4*)(colscale + col);
                        const f32x4 v = rv + acc[ai][bj][m][n] * sc;
                        *(f32x4*)(out + (size_t)row * DM + col) = v;
                        u32x2 w; w.x = cvt_pk_bf16(v[0], v[1]); w.y = cvt_pk_bf16(v[2], v[3]);
                        *(u32x2*)(xb + (size_t)row * DM + col) = w;
                        sq += (v[0] * v[0] + v[1] * v[1]) + (v[2] * v[2] + v[3] * v[3]);
                    }
                sq += __shfl_xor(sq, 16); sq += __shfl_xor(sq, 32);
                if (fq == 0) ssq[(size_t)(u.pn * 4 + wc) * T + row] = sq;
            }
    }
};

struct EpiRawF32 {
    static constexpr bool PERM = false;
    float* O; int ldc; int ncols; const float* ssq;
    __device__ __forceinline__ void operator()(const f32x4 (&acc)[2][2][4][2], const Unit& u, int wr, int wc, int fr_, int fq_) const {
        int fr = fr_, fq = fq_; asm volatile("" : "+v"(fr), "+v"(fq));
        const int row0 = u.pm * BM + wr * 64 + fr;
#pragma unroll
        for (int ai = 0; ai < 2; ++ai)
#pragma unroll
            for (int m = 0; m < 4; ++m) {
                const int row = row0 + ai * HALF + m * 16;
                const float r = row_rstd(ssq, row, fq);
#pragma unroll
                for (int bj = 0; bj < 2; ++bj)
#pragma unroll
                    for (int n = 0; n < 2; ++n) {
                        const int col = u.pn * BM + bj * HALF + wc * 32 + n * 16 + 4 * fq;
                        if (col < ncols) *(f32x4*)(O + (size_t)row * ldc + col) = acc[ai][bj][m][n] * r;
                    }
            }
    }
};

struct EpiRawBf16 {
    static constexpr bool PERM = true;
    bf16_t* O; int ldc;
    __device__ __forceinline__ void operator()(const f32x4 (&acc)[2][2][4][2], const Unit& u, int wr, int wc, int fr_, int fq_) const {
        int fr = fr_, fq = fq_; asm volatile("" : "+v"(fr), "+v"(fq));
        const int row0 = u.pm * BM + wr * 64 + fr;
#pragma unroll
        for (int ai = 0; ai < 2; ++ai)
#pragma unroll
            for (int m = 0; m < 4; ++m) {
                bf16_t* rowp = O + (size_t)(row0 + ai * HALF + m * 16) * ldc + u.pn * BM + wc * 32 + 8 * fq;
#pragma unroll
                for (int bj = 0; bj < 2; ++bj) {
                    const f32x4 v0 = acc[ai][bj][m][0], v1 = acc[ai][bj][m][1];
                    u32x4 w; w.x = cvt_pk_bf16(v0[0], v0[1]); w.y = cvt_pk_bf16(v0[2], v0[3]); w.z = cvt_pk_bf16(v1[0], v1[1]); w.w = cvt_pk_bf16(v1[2], v1[3]);
                    *(u32x4*)(rowp + bj * HALF) = w;
                }
            }
    }
};

template <class Epi>
__device__ __forceinline__ void gemm_phase(LAS unsigned char* lds, const Gemm g, const StaticOrder& S, const Epi& E) {
    int tid = threadIdx.x; asm volatile("" : "+v"(tid));
    const int wid = __builtin_amdgcn_readfirstlane(tid >> 6), lane = tid & 63, wr = wid >> 2, wc = wid & 3, fr = lane & 15, fq = lane >> 4;
    const int K = g.K, nt = K / BK;
    unsigned voffA[2], voffB[2];
#pragma unroll
    for (int i = 0; i < 2; ++i) { int R, C; stage_rc(tid * 16 + i * 8192, R, C); const int Rb = Epi::PERM ? ((R & ~31) + perm32(R & 31)) : R;
        voffA[i] = (unsigned)(R * g.lda + C) * 2u; voffB[i] = (unsigned)(Rb * g.ldb + C) * 2u; }
    const size_t kstep = (size_t)(BK * 2);
    const size_t hA = (size_t)HALF * g.lda * 2, hB = (size_t)HALF * g.ldb * 2;
    const size_t tA = 2 * hA, tB = 2 * hB;
    const unsigned ldsw = (unsigned)wid * 1024u;
    const int aoff = lds_byte(wr * 64 + fr, fq * 8), boff = lds_byte(wc * 32 + fr, fq * 8);
#define PG8_SA(b, h) (((b) * 2 + (h)) * HTB)
#define PG8_SB(b, h) ((4 + (b) * 2 + (h)) * HTB)
#define PG8_STAGE(bufoff, gbase, voff) do { _Pragma("unroll") for (int _i = 0; _i < 2; ++_i) \
        __builtin_amdgcn_global_load_lds((const unsigned*)((const char*)(gbase) + (voff)[_i]), (LAS unsigned*)(lds + (bufoff) + ldsw + _i * 8192), 16, 0, 0); } while (0)
#define PG8_LDA(dst, b, h) do { _Pragma("unroll") for (int m = 0; m < 4; ++m) _Pragma("unroll") for (int k = 0; k < 2; ++k) dst[m][k] = *(const LAS bf16x8*)(lds + PG8_SA(b, h) + aoff + m * 2048 + k * 1024); } while (0)
#define PG8_LDB(dst, b, h) do { _Pragma("unroll") for (int n = 0; n < 2; ++n) _Pragma("unroll") for (int k = 0; k < 2; ++k) dst[n][k] = *(const LAS bf16x8*)(lds + PG8_SB(b, h) + boff + n * 2048 + k * 1024); } while (0)
#define PG8_MMA(ai, bj, At, Bt) do { __builtin_amdgcn_s_setprio(1); _Pragma("unroll") for (int m = 0; m < 4; ++m) _Pragma("unroll") for (int n = 0; n < 2; ++n) _Pragma("unroll") for (int k = 0; k < 2; ++k) \
        acc[ai][bj][m][n] = __builtin_amdgcn_mfma_f32_16x16x32_bf16(Bt[n][k], At[m][k], acc[ai][bj][m][n], 0, 0, 0); __builtin_amdgcn_s_setprio(0); } while (0)
#define PG8_WAIT_V(n) asm volatile("s_waitcnt vmcnt(" #n ")" ::: "memory")
#define PG8_WAIT_L(n) asm volatile("s_waitcnt lgkmcnt(" #n ")" ::: "memory")
#define PG8_BAR __builtin_amdgcn_s_barrier()
#define PG8_SCHED __builtin_amdgcn_sched_barrier(0)
    Unit cur, nxt; int ui = 0;
    if (!S.next(0, cur)) return;
    f32x4 acc[2][2][4][2];
#pragma unroll
    for (int a = 0; a < 2; ++a)
#pragma unroll
        for (int b = 0; b < 2; ++b)
#pragma unroll
            for (int m = 0; m < 4; ++m)
#pragma unroll
                for (int n = 0; n < 2; ++n) acc[a][b][m][n] = (f32x4){0.f, 0.f, 0.f, 0.f};
    bf16x8 At[4][2], B0[2][2], B1[2][2];
    const char* cA = (const char*)g.A + (size_t)cur.pm * tA + (size_t)cur.pn * g.a_pn_stride; const char* cB = (const char*)g.Bt + (size_t)cur.pn * tB;
    PG8_STAGE(PG8_SB(0, 0), cB, voffB); PG8_STAGE(PG8_SB(0, 1), cB + hB, voffB); PG8_STAGE(PG8_SA(0, 0), cA, voffA); PG8_STAGE(PG8_SA(0, 1), cA + hA, voffA);
    if (wr == 1) PG8_BAR;
    PG8_WAIT_V(2); PG8_BAR;
    PG8_STAGE(PG8_SB(1, 0), cB + kstep, voffB); PG8_STAGE(PG8_SA(1, 0), cA + kstep, voffA); PG8_STAGE(PG8_SB(1, 1), cB + hB + kstep, voffB);
    PG8_WAIT_V(6); PG8_BAR;
    for (;;) {
        const bool has_next = S.next(ui + 1, nxt);
        const char* nA = has_next ? (const char*)g.A + (size_t)nxt.pm * tA + (size_t)nxt.pn * g.a_pn_stride : cA; const char* nB = has_next ? (const char*)g.Bt + (size_t)nxt.pn * tB : cB;
        for (int t = 0; t < nt; t += 2) {
            const bool last = (t == nt - 2);
            const char* a1 = cA + (size_t)(t + 1) * kstep;
            const char* a2 = last ? nA : cA + (size_t)(t + 2) * kstep; const char* b2 = last ? nB : cB + (size_t)(t + 2) * kstep;
            const char* a3 = a2 + kstep; const char* b3 = b2 + kstep;
            PG8_LDB(B0, 0, 0); PG8_LDB(B1, 0, 1); PG8_SCHED; PG8_LDA(At, 0, 0); PG8_STAGE(PG8_SA(1, 1), a1 + hA, voffA);
            PG8_WAIT_V(8); PG8_WAIT_L(0); PG8_BAR; PG8_MMA(0, 0, At, B0); PG8_MMA(0, 1, At, B1); PG8_BAR; PG8_SCHED;
            PG8_LDA(At, 0, 1); PG8_STAGE(PG8_SB(0, 0), b2, voffB); PG8_STAGE(PG8_SB(0, 1), b2 + hB, voffB); PG8_STAGE(PG8_SA(0, 0), a2, voffA);
            PG8_WAIT_V(8); PG8_WAIT_L(0); PG8_BAR; PG8_MMA(1, 0, At, B0); PG8_MMA(1, 1, At, B1); PG8_BAR; PG8_SCHED;
            PG8_LDB(B0, 1, 0); PG8_LDB(B1, 1, 1); PG8_SCHED; PG8_LDA(At, 1, 0); PG8_STAGE(PG8_SA(0, 1), a2 + hA, voffA);
            PG8_WAIT_V(8); PG8_WAIT_L(0); PG8_BAR; PG8_MMA(0, 0, At, B0); PG8_MMA(0, 1, At, B1); PG8_BAR; PG8_SCHED;
            PG8_LDA(At, 1, 1); PG8_STAGE(PG8_SB(1, 0), b3, voffB); PG8_STAGE(PG8_SB(1, 1), b3 + hB, voffB); PG8_STAGE(PG8_SA(1, 0), a3, voffA);
            PG8_WAIT_V(8); PG8_WAIT_L(0); PG8_BAR; PG8_MMA(1, 0, At, B0); PG8_MMA(1, 1, At, B1); PG8_BAR; PG8_SCHED;
        }
        if (wr == 0) PG8_BAR;
        E(acc, cur, wr, wc, fr, fq);
        if (!has_next) break;
#pragma unroll
        for (int a = 0; a < 2; ++a)
#pragma unroll
            for (int b = 0; b < 2; ++b)
#pragma unroll
                for (int m = 0; m < 4; ++m)
#pragma unroll
                    for (int n = 0; n < 2; ++n) acc[a][b][m][n] = (f32x4){0.f, 0.f, 0.f, 0.f};
        cur = nxt; cA = nA; cB = nB; ++ui;
        if (wr == 1) PG8_BAR;
    }
    PG8_WAIT_V(0);
    PG8_BAR;
#undef PG8_SA
#undef PG8_SB
#undef PG8_STAGE
#undef PG8_LDA
#undef PG8_LDB
#undef PG8_MMA
#undef PG8_WAIT_V
#undef PG8_WAIT_L
#undef PG8_BAR
#undef PG8_SCHED
}
}

__device__ __forceinline__ float wave_sum(float v) {
#pragma unroll
    for (int o = 1; o < 64; o <<= 1) v += __shfl_xor(v, o);
    return v;
}
__device__ __forceinline__ void conv_item(const float* W, int K, int N, bf16_t* WT, const float* gain, int mode, int row_off, LAS float* scr, int item, int lane) {
    const int nblk = N / 32;
    const int kb = item / nblk, nb = item % nblk, k0 = 64 * kb, n0 = 32 * nb;
    float v[32];
#pragma unroll
    for (int i = 0; i < 32; ++i) { const int kk = 2 * i + (lane >> 5); v[i] = W[(size_t)(k0 + kk) * N + n0 + (lane & 31)]; }
    if (gain) {
#pragma unroll
        for (int i = 0; i < 32; ++i) v[i] *= gain[k0 + 2 * i + (lane >> 5)];
    }
#pragma unroll
    for (int i = 0; i < 32; ++i) { const int kk = 2 * i + (lane >> 5); scr[kk * 33 + (lane & 31)] = v[i]; }
    asm volatile("s_waitcnt lgkmcnt(0)" ::: "memory");
    const int c = lane & 7;
#pragma unroll
    for (int j = 0; j < 4; ++j) {
        const int n = (lane >> 3) + 8 * j; const LAS float* s = scr + (8 * c) * 33 + n;
        u32x4 o; o.x = cvt_pk_bf16(s[0 * 33], s[1 * 33]); o.y = cvt_pk_bf16(s[2 * 33], s[3 * 33]); o.z = cvt_pk_bf16(s[4 * 33], s[5 * 33]); o.w = cvt_pk_bf16(s[6 * 33], s[7 * 33]);
        const int na = n0 + n; int row;
        if (mode == 1) { const int up = na >= FF ? 1 : 0; const int jn = na - up * FF; row = 256 * (jn >> 7) + 128 * up + (jn & 127); }
        else row = row_off + na;
        *(u32x4*)(WT + (size_t)row * K + k0 + 8 * c) = o;
    }
    asm volatile("s_waitcnt lgkmcnt(0)" ::: "memory");
}

__device__ __forceinline__ void phase0(const Params& p, LAS unsigned char* lds, int G, int c) {
    int tid = threadIdx.x; asm volatile("" : "+v"(tid));
    const int lane = tid & 63, wave = __builtin_amdgcn_readfirstlane(tid >> 6);
    LAS float* scr = (LAS float*)(lds + wave * 8704);
    const int gw = c * 8 + wave, NGW = G * 8;
    unsigned char* ws = p.ws;
    constexpr int I_IN = 16 * 176, I_OUT = 44 * 32;
    constexpr int NBIG = 8 * I_IN + 8 * I_OUT;
    constexpr int NSMALL = 256 + 128 + 32 + 128 + 128 + 384 + 576 + 1024;
    for (int item = gw; item < NBIG + NSMALL; item += NGW) {
        int r = item;
        if (r < 4 * I_IN) { const int l = r / I_IN; conv_item(p.in[6] + (size_t)l * 1024 * 5632, 1024, 5632, (bf16_t*)(ws + WS_WIN + (size_t)(2 * l) * SZ_WIN), p.in[5] + l * 1024, 1, 0, scr, r % I_IN, lane); continue; } r -= 4 * I_IN;
        if (r < 4 * I_IN) { const int l = r / I_IN; conv_item(p.in[10] + (size_t)l * 1024 * 5632, 1024, 5632, (bf16_t*)(ws + WS_WIN + (size_t)(2 * l + 1) * SZ_WIN), p.in[9] + l * 1024, 1, 0, scr, r % I_IN, lane); continue; } r -= 4 * I_IN;
        if (r < 4 * I_OUT) { const int l = r / I_OUT; conv_item(p.in[7] + (size_t)l * 2816 * 1024, 2816, 1024, (bf16_t*)(ws + WS_WOUT + (size_t)(2 * l) * SZ_WOUT), nullptr, 0, 0, scr, r % I_OUT, lane); continue; } r -= 4 * I_OUT;
        if (r < 4 * I_OUT) { const int l = r / I_OUT; conv_item(p.in[11] + (size_t)l * 2816 * 1024, 2816, 1024, (bf16_t*)(ws + WS_WOUT + (size_t)(2 * l + 1) * SZ_WOUT), nullptr, 0, 0, scr, r % I_OUT, lane); continue; } r -= 4 * I_OUT;
        if (r < 256) { const int lg = r >> 5; conv_item(p.in[12] + (size_t)lg * 65536, 256, 256, (bf16_t*)(ws + WS_WPOOL) + (size_t)(lg >> 2) * 1024 * 256, nullptr, 0, (lg & 3) * 256, scr, r & 31, lane); continue; } r -= 256;
        if (r < 128) { conv_item(p.in[15], 1024, 256, (bf16_t*)(ws + WS_WDKV), p.in[14], 0, 0, scr, r, lane); continue; } r -= 128;
        if (r < 32) { conv_item(p.in[17], 1024, 64, (bf16_t*)(ws + WS_WDKV), p.in[14], 0, 256, scr, r, lane); continue; } r -= 32;
        if (r < 128) { conv_item(p.in[19], 256, 1024, (bf16_t*)(ws + WS_WUK), nullptr, 0, 0, scr, r, lane); continue; } r -= 128;
        if (r < 128) { conv_item(p.in[21], 256, 1024, (bf16_t*)(ws + WS_WUV), nullptr, 0, 0, scr, r, lane); continue; } r -= 128;
        if (r < 384) { const int i = r / 192; conv_item(p.in[22] + (size_t)i * 1024 * 384, 1024, 384, (bf16_t*)(ws + WS_WDQ) + (size_t)i * 512 * 1024, p.in[8] + (2 + i) * 1024, 0, 0, scr, r % 192, lane); continue; } r -= 384;
        if (r < 576) { const int i = r / 288; conv_item(p.in[24] + (size_t)i * 384 * 1536, 384, 1536, (bf16_t*)(ws + WS_WUQ) + (size_t)i * 1536 * 384, p.in[23] + i * 384, 0, 0, scr, r % 288, lane); continue; } r -= 576;
        { const int i = r / 512; conv_item(p.in[27] + (size_t)i * 1024 * 1024, 1024, 1024, (bf16_t*)(ws + WS_WO) + (size_t)i * 1024 * 1024, nullptr, 0, 0, scr, r % 512, lane); }
    }
    {
        const int gt = c * NTHREADS + tid, NGT = G * NTHREADS;
        const u32x4 z = (u32x4){0u, 0u, 0u, 0u};
        u32x4* d0 = (u32x4*)((bf16_t*)(ws + WS_WDKV) + (size_t)320 * 1024);
        for (int i = gt; i < 192 * 1024 / 8; i += NGT) d0[i] = z;
        for (int q = 0; q < 2; ++q) { u32x4* d1 = (u32x4*)((bf16_t*)(ws + WS_WDQ) + (size_t)q * 512 * 1024 + (size_t)384 * 1024);
            for (int i = gt; i < 128 * 1024 / 8; i += NGT) d1[i] = z; }
        float* ct = (float*)(ws + WS_ROPE); float* st = ct + 2048 * 32;
        for (int i = gt; i < 2048 * 32; i += NGT) {
            const int pos = i >> 5, j = i & 31;
            const float inv = exp2f(-(float)j * 0.41524101186092029f);
            const float rev = (float)pos * inv * 0.15915494309189535f;
            const float fr = rev - floorf(rev);
            ct[i] = __builtin_amdgcn_cosf(fr); st[i] = __builtin_amdgcn_sinf(fr);
        }
    }
    {
        bf16_t* xb = (bf16_t*)(ws + WS_XB); float* ssq = (float*)(ws + WS_SSQ);
        for (int row0 = gw * 4; row0 < T; row0 += NGW * 4) {
            f32x4 v[4][4];
#pragma unroll
            for (int q = 0; q < 4; ++q) {
                const int row = row0 + q;
                const float* xr = (row < TP) ? p.in[0] + (size_t)row * DM : p.in[1] + (size_t)(row - TP) * DM;
#pragma unroll
                for (int j = 0; j < 4; ++j) v[q][j] = *(const f32x4*)(xr + 4 * lane + 256 * j);
            }
#pragma unroll
            for (int q = 0; q < 4; ++q) {
                const int row = row0 + q;
                float s = 0.f;
#pragma unroll
                for (int j = 0; j < 4; ++j) {
                    const f32x4 w4 = v[q][j];
                    s += (w4[0] * w4[0] + w4[1] * w4[1]) + (w4[2] * w4[2] + w4[3] * w4[3]);
                    u32x2 w; w.x = cvt_pk_bf16(w4[0], w4[1]); w.y = cvt_pk_bf16(w4[2], w4[3]);
                    *(u32x2*)(xb + (size_t)row * DM + 4 * lane + 256 * j) = w;
                }
                s = wave_sum(s);
                if (lane < 16) ssq[(size_t)lane * T + row] = (lane == 0) ? s : 0.f;
            }
        }
    }
}

template <int W>
__device__ __forceinline__ void pool_item(const float* x, const float* prev, bool samp, int rowbase, int s0, int S, int start, int col, int grp, f32x2 g2,
                                          const LAS float* lrs, bf16_t* Dp, float* opool) {
    f32x2 h[31 + W];
#pragma unroll
    for (int j = -(W - 1); j < 32; ++j) {
        const int s = s0 + j;
        const float* src = (s >= 0) ? x + (size_t)(rowbase + s) * DM + col : (samp ? prev + (size_t)(15 + s) * DM + col : x + (size_t)rowbase * DM + col);
        h[j + W - 1] = *(const f32x2*)src;
    }
#pragma unroll
    for (int j = -(W - 1); j < 32; ++j) {
        const int s = s0 + j;
        f32x2 sc;
        if (s >= 0) { const float r = lrs[j + 15]; sc = (f32x2){r * g2.x, r * g2.y}; }
        else sc = samp ? (f32x2){1.f, 1.f} : (f32x2){0.f, 0.f};
        h[j + W - 1] = h[j + W - 1] * sc;
    }
    f32x2 sum = (f32x2){0.f, 0.f};
#pragma unroll
    for (int j = 0; j < W - 1; ++j) sum += h[j];
#pragma unroll
    for (int j = 0; j < 32; ++j) {
        const int s = s0 + j;
        const f32x2 hs = h[j + W - 1]; sum += hs;
        const int pos = start + s; const int cnt = (pos + 1 < W) ? pos + 1 : W;
        const float ic = 1.0f / (float)cnt;
        const f32x2 d = (f32x2){sum.x * ic - hs.x, sum.y * ic - hs.y};
        *(unsigned*)(Dp + ((size_t)grp * T + rowbase + s) * 256 + (col & 255)) = cvt_pk_bf16(d.x, d.y);
        if (s >= S - 15) *(f32x2*)(opool + (size_t)(s - (S - 15)) * DM + col) = hs;
        sum -= h[j];
    }
}
__device__ __forceinline__ void pool_prep(const Params& p, int layer, const float* ssq, LAS unsigned char* lds, int G, int c) {
    int tid = threadIdx.x; asm volatile("" : "+v"(tid));
    LAS float* lrs = (LAS float*)lds;
    const float* x = p.out;
    const float* gain = p.in[8] + layer * DM;
    bf16_t* Dp = (bf16_t*)(p.ws + WS_D);
    const int col = 2 * tid, grp = __builtin_amdgcn_readfirstlane(tid >> 7);
    const f32x2 g2 = *(const f32x2*)(gain + col);
    for (int item = c; item < 2048 + 8; item += G) {
        const bool samp = item >= 2048;
        int b, s0, S, rowbase, start;
        if (!samp) { b = item >> 6; s0 = (item & 63) * 32; rowbase = b * SEQ; S = SEQ; start = 0; }
        else { b = item - 2048; s0 = 0; rowbase = TP + b * DSEQ; S = DSEQ; start = PAST; }
        if (tid < 47) {
            const int s = s0 - 15 + tid; float r = 0.f;
            if (s >= 0) { const int row = rowbase + s; float sum = 0.f;
#pragma unroll
                for (int j = 0; j < 16; ++j) sum += ssq[(size_t)j * T + row];
                r = fast_rsqrt(sum * (1.0f / 1024.0f) + EPS); }
            lrs[tid] = r;
        }
        __syncthreads();
        const float* prev = p.in[2] + ((size_t)(layer * DBATCH + b) * 15) * DM;
        float* opool = samp ? p.out + OUT_POOL_S + ((size_t)(layer * DBATCH + b) * 15) * DM : p.out + OUT_POOL_P + ((size_t)(layer * NBATCH + b) * 15) * DM;
        if (grp == 0) pool_item<2>(x, prev, samp, rowbase, s0, S, start, col, grp, g2, lrs, Dp, opool);
        else if (grp == 1) pool_item<4>(x, prev, samp, rowbase, s0, S, start, col, grp, g2, lrs, Dp, opool);
        else if (grp == 2) pool_item<8>(x, prev, samp, rowbase, s0, S, start, col, grp, g2, lrs, Dp, opool);
        else pool_item<16>(x, prev, samp, rowbase, s0, S, start, col, grp, g2, lrs, Dp, opool);
        __syncthreads();
    }
}

__device__ __forceinline__ void latent_norm(const Params& p, int G, int c) {
    int tid = threadIdx.x; asm volatile("" : "+v"(tid));
    const int lane = tid & 63, wave = tid >> 6;
    const int gw = c * 8 + wave, NGW = G * 8;
    const float* raw = (const float*)(p.ws + WS_LATRAW);
    bf16_t* call = (bf16_t*)(p.ws + WS_CALL); bf16_t* krb = (bf16_t*)(p.ws + WS_KR);
    const float* ct = (const float*)(p.ws + WS_ROPE); const float* st = ct + 2048 * 32;
    const f32x4 cg4 = *(const f32x4*)(p.in[16] + 4 * lane);
    const float kg = p.in[18][lane];
    for (int row = gw; row < T; row += NGW) {
        const float* rr = raw + (size_t)row * LATW;
        const f32x4 v = *(const f32x4*)(rr + 4 * lane);
        const float kv = rr[256 + lane];
        const float sc = wave_sum((v[0] * v[0] + v[1] * v[1]) + (v[2] * v[2] + v[3] * v[3]));
        const float sk = wave_sum(kv * kv);
        const float rc = fast_rsqrt(sc * (1.0f / 256.0f) + EPS), rk = fast_rsqrt(sk * (1.0f / 64.0f) + EPS);
        const f32x4 cv = (f32x4){v[0] * rc * cg4[0], v[1] * rc * cg4[1], v[2] * rc * cg4[2], v[3] * rc * cg4[3]};
        const float kn = kv * rk * kg;
        int pos, krow; float* oc; float* ok;
        if (row < TP) { pos = row & (SEQ - 1); krow = row; oc = p.out + OUT_CKV_P + (size_t)row * 256; ok = p.out + OUT_KR_P + (size_t)row * 64; }
        else { const int r2 = row - TP, b = r2 >> 5, s = r2 & 31; pos = PAST + s; krow = TP + b * SKEY + PAST + s; oc = p.out + OUT_CKV_S + (size_t)r2 * 256; ok = p.out + OUT_KR_S + (size_t)r2 * 64; }
        const float other = __shfl_xor(kn, 32);
        const float cs = ct[pos * 32 + (lane & 31)], sn = st[pos * 32 + (lane & 31)];
        const float ko = (lane < 32) ? (kn * cs - other * sn) : (kn * cs + other * sn);
        *(f32x4*)(oc + 4 * lane) = cv;
        ok[lane] = ko;
        u32x2 w; w.x = cvt_pk_bf16(cv[0], cv[1]); w.y = cvt_pk_bf16(cv[2], cv[3]);
        *(u32x2*)(call + (size_t)krow * 256 + 4 * lane) = w;
        const float kon = __shfl_down(ko, 1);
        if ((lane & 1) == 0) *(unsigned*)(krb + (size_t)krow * 64 + lane) = cvt_pk_bf16(ko, kon);
    }
    for (int r = gw; r < DBATCH * SKEY; r += NGW) {
        const int b = r / SKEY, t = r % SKEY; const int krow = TP + r;
        if (t >= PAST && t < PAST + DSEQ) continue;
        u32x2 w = (u32x2){0u, 0u}; unsigned kw = 0u;
        if (t < PAST) {
            const f32x4 v = *(const f32x4*)(p.in[3] + ((size_t)b * PAST + t) * 256 + 4 * lane);
            w.x = cvt_pk_bf16(v[0], v[1]); w.y = cvt_pk_bf16(v[2], v[3]);
            if (lane < 32) { const f32x2 k2 = *(const f32x2*)(p.in[4] + ((size_t)b * PAST + t) * 64 + 2 * lane); kw = cvt_pk_bf16(k2.x, k2.y); }
        }
        *(u32x2*)(call + (size_t)krow * 256 + 4 * lane) = w;
        if (lane < 32) *(unsigned*)(krb + (size_t)krow * 64 + 2 * lane) = kw;
    }
}

__device__ __forceinline__ void unpack16(const u32x4 a, const u32x4 b, float (&v)[16]) {
    v[0] = bflo(a.x); v[1] = bfhi(a.x); v[2] = bflo(a.y); v[3] = bfhi(a.y); v[4] = bflo(a.z); v[5] = bfhi(a.z); v[6] = bflo(a.w); v[7] = bfhi(a.w);
    v[8] = bflo(b.x); v[9] = bfhi(b.x); v[10] = bflo(b.y); v[11] = bfhi(b.y); v[12] = bflo(b.z); v[13] = bfhi(b.z); v[14] = bflo(b.w); v[15] = bfhi(b.w);
}
__device__ __forceinline__ void k_assemble(const Params& p, int G, int c) {
    int tid = threadIdx.x; asm volatile("" : "+v"(tid));
    const int lane = tid & 63, wave = tid >> 6;
    const int gw = c * 8 + wave, NGW = G * 8;
    bf16_t* kn = (bf16_t*)(p.ws + WS_KN);
    const float* g = p.in[20] + (lane & 7) * 16;
    float gg[16];
#pragma unroll
    for (int i = 0; i < 16; ++i) gg[i] = g[i];
    for (int row0 = gw * 4; row0 < TALL; row0 += NGW * 4) {
        u32x4 a[4], b[4];
#pragma unroll
        for (int q = 0; q < 4; ++q) { const u32x4* ptr = (const u32x4*)(kn + (size_t)(row0 + q) * 1024 + lane * 16); a[q] = ptr[0]; b[q] = ptr[1]; }
#pragma unroll
        for (int q = 0; q < 4; ++q) {
            float v[16]; unpack16(a[q], b[q], v);
            float s = 0.f;
#pragma unroll
            for (int i = 0; i < 16; ++i) s += v[i] * v[i];
            s += __shfl_xor(s, 1); s += __shfl_xor(s, 2); s += __shfl_xor(s, 4);
            const float r = fast_rsqrt(s * (1.0f / 128.0f) + EPS);
            u32x4 oa, ob;
            oa.x = cvt_pk_bf16(v[0] * r * gg[0], v[1] * r * gg[1]); oa.y = cvt_pk_bf16(v[2] * r * gg[2], v[3] * r * gg[3]);
            oa.z = cvt_pk_bf16(v[4] * r * gg[4], v[5] * r * gg[5]); oa.w = cvt_pk_bf16(v[6] * r * gg[6], v[7] * r * gg[7]);
            ob.x = cvt_pk_bf16(v[8] * r * gg[8], v[9] * r * gg[9]); ob.y = cvt_pk_bf16(v[10] * r * gg[10], v[11] * r * gg[11]);
            ob.z = cvt_pk_bf16(v[12] * r * gg[12], v[13] * r * gg[13]); ob.w = cvt_pk_bf16(v[14] * r * gg[14], v[15] * r * gg[15]);
            u32x4* ptr = (u32x4*)(kn + (size_t)(row0 + q) * 1024 + lane * 16);
            ptr[0] = oa; ptr[1] = ob;
        }
    }
}

__device__ __forceinline__ void qlat_norm(const Params& p, int G, int c) {
    int tid = threadIdx.x; asm volatile("" : "+v"(tid));
    const int lane = tid & 63, wave = tid >> 6;
    const int gw = c * 8 + wave, NGW = G * 8;
    const float* raw = (const float*)(p.ws + WS_DQRAW); bf16_t* ql = (bf16_t*)(p.ws + WS_QLAT);
    for (int row0 = gw * 4; row0 < T; row0 += NGW * 4) {
        f32x2 v[4][3];
#pragma unroll
        for (int q = 0; q < 4; ++q)
#pragma unroll
            for (int j = 0; j < 3; ++j) v[q][j] = *(const f32x2*)(raw + (size_t)(row0 + q) * QL + 2 * lane + 128 * j);
#pragma unroll
        for (int q = 0; q < 4; ++q) {
            float s = 0.f;
#pragma unroll
            for (int j = 0; j < 3; ++j) s += v[q][j].x * v[q][j].x + v[q][j].y * v[q][j].y;
            s = wave_sum(s);
            const float r = fast_rsqrt(s * (1.0f / 384.0f) + EPS);
#pragma unroll
            for (int j = 0; j < 3; ++j) *(unsigned*)(ql + (size_t)(row0 + q) * QL + 2 * lane + 128 * j) = cvt_pk_bf16(v[q][j].x * r, v[q][j].y * r);
        }
    }
}

__device__ __forceinline__ void q_assemble(const Params& p, int i, int G, int c) {
    int tid = threadIdx.x; asm volatile("" : "+v"(tid));
    const int lane = tid & 63, wave = tid >> 6;
    const int gw = c * 8 + wave, NGW = G * 8;
    bf16_t* Q = (bf16_t*)(p.ws + WS_Q);
    const float* ct = (const float*)(p.ws + WS_ROPE); const float* st = ct + 2048 * 32;
    const int head = lane >> 3, sub = lane & 7;
    const float SC = 0.07216878364870323f * 1.4426950408889634f;
    float gn[16], gr[8];
#pragma unroll
    for (int j = 0; j < 16; ++j) gn[j] = p.in[25][i * 128 + sub * 16 + j] * SC;
#pragma unroll
    for (int j = 0; j < 8; ++j) gr[j] = p.in[26][i * 64 + sub * 8 + j];
    const int jb = (sub & 3) * 8;
    for (int row0 = gw * 2; row0 < T; row0 += NGW * 2) {
        u32x4 a[2], b[2], rw[2]; f32x4 c0[2], c1[2], n0[2], n1[2];
#pragma unroll
        for (int q = 0; q < 2; ++q) {
            const int row = row0 + q;
            const int pos = (row < TP) ? (row & (SEQ - 1)) : (PAST + ((row - TP) & 31));
            const bf16_t* qh = Q + (size_t)row * HQ + head * 192;
            const u32x4* pn = (const u32x4*)(qh + sub * 16); const u32x4* pr = (const u32x4*)(qh + 128 + sub * 8);
            a[q] = pn[0]; b[q] = pn[1]; rw[q] = pr[0];
            c0[q] = *(const f32x4*)(ct + pos * 32 + jb); c1[q] = *(const f32x4*)(ct + pos * 32 + jb + 4);
            n0[q] = *(const f32x4*)(st + pos * 32 + jb); n1[q] = *(const f32x4*)(st + pos * 32 + jb + 4);
        }
#pragma unroll
        for (int q = 0; q < 2; ++q) {
            const int row = row0 + q;
            bf16_t* qh = Q + (size_t)row * HQ + head * 192;
            u32x4* pn = (u32x4*)(qh + sub * 16); u32x4* pr = (u32x4*)(qh + 128 + sub * 8);
            float v[16], rv[8];
            unpack16(a[q], b[q], v);
            rv[0] = bflo(rw[q].x); rv[1] = bfhi(rw[q].x); rv[2] = bflo(rw[q].y); rv[3] = bfhi(rw[q].y); rv[4] = bflo(rw[q].z); rv[5] = bfhi(rw[q].z); rv[6] = bflo(rw[q].w); rv[7] = bfhi(rw[q].w);
            float s = 0.f, s2 = 0.f;
#pragma unroll
            for (int j = 0; j < 16; ++j) s += v[j] * v[j];
#pragma unroll
            for (int j = 0; j < 8; ++j) s2 += rv[j] * rv[j];
            s += __shfl_xor(s, 1); s += __shfl_xor(s, 2); s += __shfl_xor(s, 4);
            s2 += __shfl_xor(s2, 1); s2 += __shfl_xor(s2, 2); s2 += __shfl_xor(s2, 4);
            const float rn = fast_rsqrt(s * (1.0f / 128.0f) + EPS), rr = fast_rsqrt(s2 * (1.0f / 64.0f) + EPS);
            u32x4 oa, ob;
            oa.x = cvt_pk_bf16(v[0] * rn * gn[0], v[1] * rn * gn[1]); oa.y = cvt_pk_bf16(v[2] * rn * gn[2], v[3] * rn * gn[3]);
            oa.z = cvt_pk_bf16(v[4] * rn * gn[4], v[5] * rn * gn[5]); oa.w = cvt_pk_bf16(v[6] * rn * gn[6], v[7] * rn * gn[7]);
            ob.x = cvt_pk_bf16(v[8] * rn * gn[8], v[9] * rn * gn[9]); ob.y = cvt_pk_bf16(v[10] * rn * gn[10], v[11] * rn * gn[11]);
            ob.z = cvt_pk_bf16(v[12] * rn * gn[12], v[13] * rn * gn[13]); ob.w = cvt_pk_bf16(v[14] * rn * gn[14], v[15] * rn * gn[15]);
            pn[0] = oa; pn[1] = ob;
            float o[8];
#pragma unroll
            for (int j = 0; j < 8; ++j) {
                const float me = rv[j] * rr * gr[j];
                const float other = __shfl_xor(me, 4);
                const float cs = (j < 4) ? c0[q][j & 3] : c1[q][j & 3], sn = (j < 4) ? n0[q][j & 3] : n1[q][j & 3];
                o[j] = ((sub < 4) ? (me * cs - other * sn) : (me * cs + other * sn)) * SC;
            }
            u32x4 orr; orr.x = cvt_pk_bf16(o[0], o[1]); orr.y = cvt_pk_bf16(o[2], o[3]); orr.z = cvt_pk_bf16(o[4], o[5]); orr.w = cvt_pk_bf16(o[6], o[7]);
            pr[0] = orr;
        }
    }
}

#define MFMA32(a, b, c) __builtin_amdgcn_mfma_f32_32x32x16_bf16((a), (b), (c), 0, 0, 0)
constexpr int KSTR = 400, VSTR = 144, KBUF = 64 * KSTR, VBUF = 128 * VSTR, ABUF = KBUF + VBUF;
__device__ __forceinline__ void attn_phase(const Params& p, LAS unsigned char* lds, int G, int c) {
    int tid = threadIdx.x; asm volatile("" : "+v"(tid));
    const int wid = __builtin_amdgcn_readfirstlane(tid >> 6), lane = tid & 63, l32 = lane & 31, hi = lane >> 5;
    const bf16_t* Q = (const bf16_t*)(p.ws + WS_Q); const bf16_t* KN = (const bf16_t*)(p.ws + WS_KN); const bf16_t* KR = (const bf16_t*)(p.ws + WS_KR);
    const bf16_t* VT = (const bf16_t*)(p.ws + WS_VT); bf16_t* O = (bf16_t*)(p.ws + WS_O);
    for (int idx = c; idx < 2048 + 64; idx += G) {
        int h, qrow0, krow0, ntiles, wave_last; bool partial;
        if (idx < 2048) { const int bh = idx & 255, r = idx >> 8, qblk = (r & 1) ? (r >> 1) : 7 - (r >> 1), b = bh >> 3; h = bh & 7;
            qrow0 = b * SEQ + qblk * 256; krow0 = b * SEQ; ntiles = 4 * qblk + 4; wave_last = 4 * qblk + (wid >> 1); partial = false; }
        else { const int s = idx - 2048, b = s >> 3; h = s & 7; qrow0 = TP + b * DSEQ; krow0 = TP + b * SKEY; ntiles = 17; wave_last = (wid == 0) ? 16 : -1; partial = true; }
        const bool active = wave_last >= 0;
        bf16x8 qf[12];
        if (active) {
            const bf16_t* qp = Q + (size_t)(qrow0 + wid * 32 + l32) * HQ + h * 192 + hi * 8;
#pragma unroll
            for (int kk = 0; kk < 12; ++kk) qf[kk] = *(const bf16x8*)(qp + kk * 16);
        } else {
#pragma unroll
            for (int kk = 0; kk < 12; ++kk) qf[kk] = (bf16x8){0, 0, 0, 0, 0, 0, 0, 0};
        }
        f32x16 o[4];
#pragma unroll
        for (int d = 0; d < 4; ++d)
#pragma unroll
            for (int r = 0; r < 16; ++r) o[d][r] = 0.f;
        float mrun = -INFINITY, lsum = 0.f;
        const int kp0 = tid, kp1 = tid + 512;
        const int rk = tid >> 3, rc = tid & 7;
        const int vp0 = tid, vp1 = tid + 512;
        const bf16_t* gk0 = KN + (size_t)(krow0 + (kp0 >> 4)) * 1024 + h * 128 + (kp0 & 15) * 8;
        const bf16_t* gk1 = KN + (size_t)(krow0 + (kp1 >> 4)) * 1024 + h * 128 + (kp1 & 15) * 8;
        const bf16_t* gr = KR + (size_t)(krow0 + rk) * 64 + rc * 8;
        const bf16_t* gv0 = VT + (size_t)(h * 128 + (vp0 >> 3)) * TALL + krow0 + (vp0 & 7) * 8;
        const bf16_t* gv1 = VT + (size_t)(h * 128 + (vp1 >> 3)) * TALL + krow0 + (vp1 & 7) * 8;
        const int lk0 = (kp0 >> 4) * KSTR + (kp0 & 15) * 16, lk1 = (kp1 >> 4) * KSTR + (kp1 & 15) * 16, lr = rk * KSTR + 256 + rc * 16;
        const int lv0 = KBUF + (vp0 >> 3) * VSTR + ((vp0 & 7) >> 1) * 32 + 8 * (vp0 & 1);
        const int lv1 = KBUF + (vp1 >> 3) * VSTR + ((vp1 & 7) >> 1) * 32 + 8 * (vp1 & 1);
        u32x4 sk0, sk1, sr, sv0, sv1;
#define ATT_LOAD(t) do { sk0 = *(const u32x4*)(gk0 + (size_t)(t) * 64 * 1024); sk1 = *(const u32x4*)(gk1 + (size_t)(t) * 64 * 1024); sr = *(const u32x4*)(gr + (size_t)(t) * 64 * 64); \
                         sv0 = *(const u32x4*)(gv0 + (t) * 64); sv1 = *(const u32x4*)(gv1 + (t) * 64); } while (0)
#define ATT_WRITE(bufp) do { LAS unsigned char* _b = (bufp); *(LAS u32x4*)(_b + lk0) = sk0; *(LAS u32x4*)(_b + lk1) = sk1; *(LAS u32x4*)(_b + lr) = sr; \
                         *(LAS u32x2*)(_b + lv0) = (u32x2){sv0.x, sv0.y}; *(LAS u32x2*)(_b + lv0 + 16) = (u32x2){sv0.z, sv0.w}; \
                         *(LAS u32x2*)(_b + lv1) = (u32x2){sv1.x, sv1.y}; *(LAS u32x2*)(_b + lv1 + 16) = (u32x2){sv1.z, sv1.w}; } while (0)
        ATT_LOAD(0);
        ATT_WRITE(lds);
        __syncthreads();
        for (int t = 0; t < ntiles; ++t) {
            LAS unsigned char* buf = lds + (t & 1) * ABUF;
            if (t + 1 < ntiles) ATT_LOAD(t + 1);
            if (t <= wave_last) {
                f32x16 s0, s1;
#pragma unroll
                for (int r = 0; r < 16; ++r) { s0[r] = 0.f; s1[r] = 0.f; }
                const LAS unsigned char* kb = buf + l32 * KSTR + hi * 16;
#pragma unroll
                for (int kk = 0; kk < 12; ++kk) {
                    const bf16x8 a0 = *(const LAS bf16x8*)(kb + kk * 32);
                    const bf16x8 a1 = *(const LAS bf16x8*)(kb + 32 * KSTR + kk * 32);
                    s0 = MFMA32(a0, qf[kk], s0);
                    s1 = MFMA32(a1, qf[kk], s1);
                }
                if (partial && t == ntiles - 1) {
#pragma unroll
                    for (int r = 0; r < 16; ++r) s1[r] = -INFINITY;
                }
                float mx = s0[0];
#pragma unroll
                for (int r = 1; r < 16; ++r) mx = fmaxf(mx, s0[r]);
#pragma unroll
                for (int r = 0; r < 16; ++r) mx = fmaxf(mx, s1[r]);
                mx = fmaxf(mx, __shfl_xor(mx, 32));
                const float mnew = fmaxf(mrun, mx);
                const float alpha = __builtin_amdgcn_exp2f(mrun - mnew);
                mrun = mnew;
                float rs = 0.f;
#pragma unroll
                for (int r = 0; r < 16; ++r) { s0[r] = __builtin_amdgcn_exp2f(s0[r] - mnew); s1[r] = __builtin_amdgcn_exp2f(s1[r] - mnew); rs += s0[r] + s1[r]; }
                lsum = lsum * alpha + rs;
#pragma unroll
                for (int d = 0; d < 4; ++d)
#pragma unroll
                    for (int r = 0; r < 16; ++r) o[d][r] *= alpha;
                bf16x8 pf[4];
                {
                    u32x4 w;
                    w.x = cvt_pk_bf16(s0[0], s0[1]); w.y = cvt_pk_bf16(s0[2], s0[3]); w.z = cvt_pk_bf16(s0[4], s0[5]); w.w = cvt_pk_bf16(s0[6], s0[7]); pf[0] = __builtin_bit_cast(bf16x8, w);
                    w.x = cvt_pk_bf16(s0[8], s0[9]); w.y = cvt_pk_bf16(s0[10], s0[11]); w.z = cvt_pk_bf16(s0[12], s0[13]); w.w = cvt_pk_bf16(s0[14], s0[15]); pf[1] = __builtin_bit_cast(bf16x8, w);
                    w.x = cvt_pk_bf16(s1[0], s1[1]); w.y = cvt_pk_bf16(s1[2], s1[3]); w.z = cvt_pk_bf16(s1[4], s1[5]); w.w = cvt_pk_bf16(s1[6], s1[7]); pf[2] = __builtin_bit_cast(bf16x8, w);
                    w.x = cvt_pk_bf16(s1[8], s1[9]); w.y = cvt_pk_bf16(s1[10], s1[11]); w.z = cvt_pk_bf16(s1[12], s1[13]); w.w = cvt_pk_bf16(s1[14], s1[15]); pf[3] = __builtin_bit_cast(bf16x8, w);
                }
                const LAS unsigned char* vb = buf + KBUF + l32 * VSTR + hi * 16;
#pragma unroll
                for (int d = 0; d < 4; ++d)
#pragma unroll
                    for (int ks = 0; ks < 4; ++ks) {
                        const bf16x8 vf = *(const LAS bf16x8*)(vb + d * 32 * VSTR + ks * 32);
                        o[d] = MFMA32(vf, pf[ks], o[d]);
                    }
            }
            if (t + 1 < ntiles) ATT_WRITE(lds + ((t + 1) & 1) * ABUF);
            __syncthreads();
        }
        if (active) {
            const float l = lsum + __shfl_xor(lsum, 32);
            const float inv = 1.0f / l;
            bf16_t* op = O + (size_t)(qrow0 + wid * 32 + l32) * DM + h * 128 + 4 * hi;
#pragma unroll
            for (int d = 0; d < 4; ++d)
#pragma unroll
                for (int g4 = 0; g4 < 4; ++g4) {
                    u32x2 w; w.x = cvt_pk_bf16(o[d][4 * g4] * inv, o[d][4 * g4 + 1] * inv); w.y = cvt_pk_bf16(o[d][4 * g4 + 2] * inv, o[d][4 * g4 + 3] * inv);
                    *(u32x2*)(op + d * 32 + 8 * g4) = w;
                }
        }
#undef ATT_LOAD
#undef ATT_WRITE
    }
}

#define XB_TMO      128
#define XB_XCNT(j)  (256  + 64 * (j))
#define XB_XSUB(j)  (1280 + 64 * (j))
#define XB_XGEN(j)  (2304 + 64 * (j))
#define XB_TOP      3328
#define XB_TOPGEN   3392
#define XCD_BAR_WORDS 3456
#define XB_SPIN_CAP (1u << 18)
__device__ __forceinline__ unsigned xb_ld(unsigned* p)              { return __hip_atomic_load(p, __ATOMIC_RELAXED, __HIP_MEMORY_SCOPE_AGENT); }
__device__ __forceinline__ unsigned xb_add(unsigned* p, unsigned v) { return __hip_atomic_fetch_add(p, v, __ATOMIC_RELAXED, __HIP_MEMORY_SCOPE_AGENT); }
__device__ __forceinline__ unsigned xb_xcc_id() { return (unsigned)__builtin_amdgcn_s_getreg((3 << 11) | 20) & 0xFu; }
#define XB_SPIN(cond, bar) do { unsigned _sp = 0; while (cond) { __builtin_amdgcn_s_sleep(1); \
    if ((++_sp & 255u) == 0u) { if (xb_ld(&(bar)[XB_TMO])) break; if (_sp > XB_SPIN_CAP) { atomicAdd(&(bar)[XB_TMO], 1u); break; } } } } while (0)
struct XcdBarrier { unsigned* bar; unsigned x; volatile LAS unsigned* st; };
__device__ __forceinline__ XcdBarrier xcd_barrier_post(unsigned* bar, volatile LAS unsigned* st) {
    XcdBarrier b; b.bar = bar; b.x = xb_xcc_id(); b.st = st;
    if (threadIdx.x == 0) (void)xb_add(&bar[XB_XCNT(b.x)], 1u);
    return b;
}
__device__ __forceinline__ void xcd_barrier_complete(unsigned* bar, unsigned x, unsigned& nloc, unsigned& nx) {
    const unsigned G = gridDim.x * gridDim.y * gridDim.z;
    unsigned sum, cnt, mine, sp = 0u;
    for (;;) {
        sum = 0u; cnt = 0u; mine = 0u;
#pragma unroll
        for (unsigned j = 0; j < 16; ++j) { const unsigned c = xb_ld(&bar[XB_XCNT(j)]); sum += c; cnt += (c > 0u) ? 1u : 0u; mine = (j == x) ? c : mine; }
        if (sum == G) break;
        __builtin_amdgcn_s_sleep(1);
        if ((++sp & 255u) == 0u) { if (xb_ld(&bar[XB_TMO])) break; if (sp > XB_SPIN_CAP) { atomicAdd(&bar[XB_TMO], 1u); break; } }
    }
    nloc = mine > 0u ? mine : 1u; nx = cnt > 0u ? cnt : 1u;
}
__device__ __forceinline__ void xcd_barrier(const XcdBarrier& b) {
    asm volatile("s_waitcnt vmcnt(0)" ::: "memory");
    __syncthreads();
    if (threadIdx.x == 0) {
        unsigned* bar = b.bar;
        __builtin_amdgcn_s_waitcnt(0);
        unsigned nloc = b.st[0], nx = b.st[1];
        if (nloc == 0u) { xcd_barrier_complete(bar, b.x, nloc, nx); b.st[0] = nloc; b.st[1] = nx; }
        const unsigned old = xb_add(&bar[XB_XSUB(b.x)], 1u);
        const unsigned gen = old / nloc;
        if (old + 1u == (gen + 1u) * nloc) {
            __builtin_amdgcn_fence(__ATOMIC_RELEASE, "agent");
            asm volatile("s_waitcnt vmcnt(0)" ::: "memory");
            const unsigned og = xb_add(&bar[XB_TOP], 1u);
            const unsigned tg = og / nx;
            if (og + 1u == (tg + 1u) * nx) xb_add(&bar[XB_TOPGEN], 1u);
            else XB_SPIN(xb_ld(&bar[XB_TOPGEN]) == tg, bar);
            __builtin_amdgcn_fence(__ATOMIC_ACQUIRE, "agent");
            xb_add(&bar[XB_XGEN(b.x)], 1u);
            asm volatile("s_waitcnt vmcnt(0)" ::: "memory");
        } else {
            XB_SPIN(xb_ld(&bar[XB_XGEN(b.x)]) == gen, bar);
            __builtin_amdgcn_fence(__ATOMIC_ACQUIRE, "agent");
            asm volatile("s_waitcnt vmcnt(0)" ::: "memory");
        }
    }
    __syncthreads();
}

__global__ void __launch_bounds__(NTHREADS, 2) yoco_fwd(Params p) {
    extern __shared__ __attribute__((aligned(16))) unsigned char lds_raw[];
    LAS unsigned char* lds = (LAS unsigned char*)lds_raw;
    cg::grid_group grid = cg::this_grid();
    const int G = gridDim.x, c = blockIdx.x;
    unsigned char* ws = p.ws;
    bf16_t* xb = (bf16_t*)(ws + WS_XB); bf16_t* Hb = (bf16_t*)(ws + WS_H);
    float* ssqb = (float*)(ws + WS_SSQ);
    float* xo = p.out;
    int cur = 0;
    volatile LAS unsigned* bst = (volatile LAS unsigned*)(lds + 131072);
    if (threadIdx.x < 4) bst[threadIdx.x] = 0u;
    __syncthreads();
    XcdBarrier xbar = xcd_barrier_post((unsigned*)(ws + WS_BAR), bst);

    for (int rep = 0; rep < DUP_P0; ++rep) { phase0(p, lds, G, c); if (rep + 1 < DUP_P0) __syncthreads(); }
    grid.sync();
#define GRID_BAR() xcd_barrier(xbar)

    for (int l = 0; l < 4; ++l) {
        for (int hf = 0; hf < 2; ++hf) {
            if (hf == 1) {
                if (l < 2) {
#ifndef NO_PP
                    pool_prep(p, l, ssqb + (size_t)cur * 16 * T, lds, G, c);
#endif
                    GRID_BAR();
                    {
                        pg8::Gemm g{(const bf16_t*)(ws + WS_D), (const bf16_t*)(ws + WS_WPOOL) + (size_t)l * 1024 * 256, 256, 256, 256, T / 256, 4, (size_t)T * 256 * 2};
                        pg8::StaticOrder S; S.init(T / 256, 4, G, c);
                        pg8::EpiResid E{xo, xo + (size_t)TP * DM, xo, xb, ssqb + (size_t)(cur ^ 1) * 16 * T, p.in[13] + l * DM, 1.0f};
#ifndef NO_EPIRESID
                        pg8::gemm_phase<pg8::EpiResid>(lds, g, S, E);
#endif
                    }
                    cur ^= 1;
                    GRID_BAR();
                } else {
                    const int i = l - 2;
                    {
                        pg8::Gemm g{xb, (const bf16_t*)(ws + WS_WDQ) + (size_t)i * 512 * 1024, 1024, 1024, 1024, T / 256, 2, 0};
                        pg8::StaticOrder S; S.init(T / 256, 2, G, c);
                        pg8::EpiRawF32 E{(float*)(ws + WS_DQRAW), QL, QL, ssqb + (size_t)cur * 16 * T};
#ifndef NO_EPIRAWF32
                        pg8::gemm_phase<pg8::EpiRawF32>(lds, g, S, E);
#endif
                    }
                    GRID_BAR();
#ifndef NO_EW
                    qlat_norm(p, G, c);
#endif
                    GRID_BAR();
                    {
                        pg8::Gemm g{(const bf16_t*)(ws + WS_QLAT), (const bf16_t*)(ws + WS_WUQ) + (size_t)i * 1536 * 384, 384, 384, 384, T / 256, 6, 0};
                        pg8::StaticOrder S; S.init(T / 256, 6, G, c);
                        pg8::EpiRawBf16 E{(bf16_t*)(ws + WS_Q), HQ};
#ifndef NO_EPIRAWBF16
                        pg8::gemm_phase<pg8::EpiRawBf16>(lds, g, S, E);
#endif
                    }
                    GRID_BAR();
#ifndef NO_QA
                    q_assemble(p, i, G, c);
#endif
                    GRID_BAR();
                    for (int rep = 0; rep < DUP_ATT; ++rep) attn_phase(p, lds, G, c);
                    GRID_BAR();
                    {
                        pg8::Gemm g{(const bf16_t*)(ws + WS_O), (const bf16_t*)(ws + WS_WO) + (size_t)i * 1024 * 1024, 1024, 1024, 1024, T / 256, 4, 0};
                        pg8::StaticOrder S; S.init(T / 256, 4, G, c);
                        pg8::EpiResid E{xo, xo + (size_t)TP * DM, xo, xb, ssqb + (size_t)(cur ^ 1) * 16 * T, nullptr, 1.0f};
#ifndef NO_EPIRESID
                        pg8::gemm_phase<pg8::EpiResid>(lds, g, S, E);
#endif
                    }
                    cur ^= 1;
                    GRID_BAR();
                }
            }
            {
                pg8::Gemm g{xb, (const bf16_t*)(ws + WS_WIN + (size_t)(2 * l + hf) * SZ_WIN), 1024, 1024, 1024, T / 256, 22, 0};
                pg8::StaticOrder S; S.init(T / 256, 22, G, c);
                pg8::EpiSwiglu E{Hb, ssqb + (size_t)cur * 16 * T};
                for (int rep = 0; rep < DUP_FFNIN; ++rep) pg8::gemm_phase<pg8::EpiSwiglu>(lds, g, S, E);
            }
            GRID_BAR();
            {
                pg8::Gemm g{Hb, (const bf16_t*)(ws + WS_WOUT + (size_t)(2 * l + hf) * SZ_WOUT), FF, FF, FF, T / 256, 4, 0};
                pg8::StaticOrder S; S.init(T / 256, 4, G, c);
                const bool first = (l == 0 && hf == 0);
                pg8::EpiResid E{first ? p.in[0] : xo, first ? p.in[1] : xo + (size_t)TP * DM, xo, xb, ssqb + (size_t)(cur ^ 1) * 16 * T, nullptr, 0.5f};
#ifndef NO_EPIRESID
                pg8::gemm_phase<pg8::EpiResid>(lds, g, S, E);
#endif
            }
            cur ^= 1;
            GRID_BAR();
        }
        if (l == 1) {
            {
                pg8::Gemm g{xb, (const bf16_t*)(ws + WS_WDKV), 1024, 1024, 1024, T / 256, 2, 0};
                pg8::StaticOrder S; S.init(T / 256, 2, G, c);
                pg8::EpiRawF32 E{(float*)(ws + WS_LATRAW), LATW, LATW, ssqb + (size_t)cur * 16 * T};
#ifndef NO_EPIRAWF32
                pg8::gemm_phase<pg8::EpiRawF32>(lds, g, S, E);
#endif
            }
            GRID_BAR();
#ifndef NO_EW
            latent_norm(p, G, c);
#endif
            GRID_BAR();
            {
                pg8::Gemm g{(const bf16_t*)(ws + WS_CALL), (const bf16_t*)(ws + WS_WUK), 256, 256, 256, TALL / 256, 4, 0};
                pg8::StaticOrder S; S.init(TALL / 256, 4, G, c);
                pg8::EpiRawBf16 E{(bf16_t*)(ws + WS_KN), 1024};
#ifndef NO_EPIRAWBF16
                pg8::gemm_phase<pg8::EpiRawBf16>(lds, g, S, E);
#endif
            }
            {
                pg8::Gemm g{(const bf16_t*)(ws + WS_WUV), (const bf16_t*)(ws + WS_CALL), 256, 256, 256, 4, TALL / 256, 0};
                pg8::StaticOrder S; S.init(4, TALL / 256, G, c);
                pg8::EpiRawBf16 E{(bf16_t*)(ws + WS_VT), TALL};
#ifndef NO_EPIRAWBF16
                pg8::gemm_phase<pg8::EpiRawBf16>(lds, g, S, E);
#endif
            }
            GRID_BAR();
#ifndef NO_KA
            k_assemble(p, G, c);
#endif
            GRID_BAR();
        }
    }
}

extern "C" void kernel_launch(void* const* d_in, const int* in_sizes, int n_in, void* d_out, int out_size, void* d_ws, size_t ws_size, hipStream_t stream) {
    static int grid_blocks = 0;
    if (grid_blocks == 0) {
        if (n_in != 28 || ws_size < WS_END) { fprintf(stderr, "kernel_launch: unexpected n_in %d or ws_size %zu (need %zu)\n", n_in, ws_size, (size_t)WS_END); }
        int dev = 0, cus = 0, per_cu = 0;
        hipGetDevice(&dev);
        hipDeviceGetAttribute(&cus, hipDeviceAttributeMultiprocessorCount, dev);
        if (hipFuncSetAttribute((const void*)yoco_fwd, hipFuncAttributeMaxDynamicSharedMemorySize, LDS_BYTES) != hipSuccess) fprintf(stderr, "kernel_launch: hipFuncSetAttribute failed\n");
        if (hipOccupancyMaxActiveBlocksPerMultiprocessor(&per_cu, (const void*)yoco_fwd, NTHREADS, LDS_BYTES) != hipSuccess || per_cu < 1) { fprintf(stderr, "kernel_launch: occupancy query gave %d\n", per_cu); per_cu = 1; }
        (void)hipGetLastError();
        grid_blocks = cus * 1;
        if (grid_blocks <= 0) grid_blocks = 256;
    }
    if (hipMemsetAsync((char*)d_ws + WS_BAR, 0, 16384, stream) != hipSuccess) fprintf(stderr, "kernel_launch: memset of barrier words failed\n");
    Params p{};
    for (int i = 0; i < 28; ++i) p.in[i] = (const float*)d_in[i];
    p.out = (float*)d_out; p.ws = (unsigned char*)d_ws;
    void* args[] = {&p};
    hipError_t e = hipLaunchCooperativeKernel((const void*)yoco_fwd, dim3(grid_blocks), dim3(NTHREADS), args, LDS_BYTES, stream);
    if (e != hipSuccess) fprintf(stderr, "cooperative launch failed: %s (grid %d)\n", hipGetErrorString(e), grid_blocks);
}
```
